# Optimizing an MI355X kernel written in HIP

```python
import jax, jax.numpy as jnp
from jax import lax
import numpy as np

D_MODEL = 2048
BATCH = 4
SEQ = 2048
DEPTH = 1
DEC_BATCH = 128
DEC_SEQ = 8
PAST_LEN = 16384
PAGE_SIZE = 128

N_META = 16
MIX_W = D_MODEL
RET_HEADS = 4
RET_DK = (MIX_W // 2) // RET_HEADS
RET_DV = (MIX_W // 2) // RET_HEADS
RET_CHUNK = 128
RET_THETA = 10000.0
SWA_HD = 64
SWA_HEADS = (MIX_W // 2) // SWA_HD
SWA_KV_HEADS = 2
SWA_GROUP = SWA_HEADS // SWA_KV_HEADS
WINDOW = 128
BUF_LEN = min(WINDOW, PAST_LEN)
ROPE_THETA = 500000.0
ROT_DIM = SWA_HD // 4
FFN_HIDDEN = -(-8 * D_MODEL // (3 * 256)) * 256
ALPHA = (2.0 * DEPTH) ** 0.25
BETA = (8.0 * DEPTH) ** -0.25
LN_EPS = 1e-5
NEG_INF = -1e30

PROJ_SIZES = (RET_HEADS * RET_DK, RET_HEADS * RET_DK, RET_HEADS * RET_DV, RET_HEADS * RET_DV,
              SWA_HEADS * SWA_HD, SWA_KV_HEADS * SWA_HD, SWA_KV_HEADS * SWA_HD)
PROJ_W = sum(PROJ_SIZES)

kernel_name = "hymba_retention_swa_sink_deepnorm_step"


def layer_norm(x, g, b):
    xf = x.astype(jnp.float32)
    mu = xf.mean(-1, keepdims=True)
    var = jnp.square(xf - mu).mean(-1, keepdims=True)
    return ((xf - mu) * lax.rsqrt(var + LN_EPS) * g + b).astype(x.dtype)


def head_group_norm(o):
    mu = o.mean(-1, keepdims=True)
    var = jnp.square(o - mu).mean(-1, keepdims=True)
    return (o - mu) * lax.rsqrt(var + LN_EPS)


def rope(x, pos, inv_freq):
    ang = pos.astype(jnp.float32)[:, None] * inv_freq[None, :]
    cos = jnp.cos(ang)[:, None, :]
    sin = jnp.sin(ang)[:, None, :]
    x1, x2 = jnp.split(x.astype(jnp.float32), 2, axis=-1)
    return jnp.concatenate([x1 * cos - x2 * sin, x2 * cos + x1 * sin], -1).astype(x.dtype)


def mixer_projections(x, pos, w_in):
    B, T, _ = x.shape
    z = jnp.einsum('btd,de->bte', x, w_in)
    split_at = np.cumsum(PROJ_SIZES)[:-1].tolist()
    rq, rk, rv, rg, sq, sk, sv = jnp.split(z, split_at, axis=-1)
    ret_freq = jnp.power(RET_THETA, -jnp.linspace(0.0, 1.0, RET_DK // 2, dtype=jnp.float32))
    rq = rope(rq.reshape(B, T, RET_HEADS, RET_DK), pos, ret_freq)
    rk = rope(rk.reshape(B, T, RET_HEADS, RET_DK), pos, ret_freq) * (RET_DK ** -0.5)
    rv = rv.reshape(B, T, RET_HEADS, RET_DV)
    rg = rg.reshape(B, T, RET_HEADS, RET_DV)
    swa_freq = jnp.power(ROPE_THETA, -jnp.arange(0, ROT_DIM, 2, dtype=jnp.float32) / ROT_DIM)
    sq = sq.reshape(B, T, SWA_HEADS, SWA_HD)
    sk = sk.reshape(B, T, SWA_KV_HEADS, SWA_HD)
    sq = jnp.concatenate([rope(sq[..., :ROT_DIM], pos, swa_freq), sq[..., ROT_DIM:]], -1)
    sk = jnp.concatenate([rope(sk[..., :ROT_DIM], pos, swa_freq), sk[..., ROT_DIM:]], -1)
    sv = sv.reshape(B, T, SWA_KV_HEADS, SWA_HD)
    return rq, rk, rv, rg, sq, sk, sv


def retention_log_gamma():
    return jnp.log(1.0 - jnp.power(2.0, -5.0 - jnp.arange(RET_HEADS, dtype=jnp.float32)))


def retention_chunk(q, k, v, s_prev, log_gamma):
    C = q.shape[1]
    qf, kf, vf = (a.astype(jnp.float32) for a in (q, k, v))
    s_prev = s_prev.astype(jnp.float32)
    idx = jnp.arange(C, dtype=jnp.float32)
    rel = idx[:, None] - idx[None, :]
    decay = jnp.where(rel[None] >= 0,
                      jnp.exp(jnp.maximum(rel, 0.0)[None] * log_gamma[:, None, None]), 0.0)
    scores = jnp.einsum('bihd,bjhd->bhij', qf, kf) * decay[None]
    inner = jnp.einsum('bhij,bjhe->bihe', scores, vf)
    q_decay = jnp.exp((idx + 1.0)[:, None] * log_gamma[None, :])
    cross = jnp.einsum('bihd,bhde->bihe', qf, s_prev) * q_decay[None, :, :, None]
    k_decay = jnp.exp((C - 1.0 - idx)[:, None] * log_gamma[None, :])
    s_new = (jnp.exp(C * log_gamma)[None, :, None, None] * s_prev
             + jnp.einsum('bjhd,bjhe,jh->bhde', kf, vf, k_decay))
    return inner + cross, s_new


def retention_prompt(q, k, v, log_gamma):
    B, L = q.shape[:2]
    s0 = jnp.zeros((B, RET_HEADS, RET_DK, RET_DV), jnp.float32)
    o_meta, s = retention_chunk(q[:, :N_META], k[:, :N_META], v[:, :N_META], s0, log_gamma)
    n_chunks = (L - N_META) // RET_CHUNK

    def to_chunks(a):
        return a[:, N_META:].reshape(B, n_chunks, RET_CHUNK, *a.shape[2:]).swapaxes(0, 1)

    def step(s_c, qkv):
        o_c, s_c = retention_chunk(qkv[0], qkv[1], qkv[2], s_c, log_gamma)
        return s_c, o_c

    s, o = lax.scan(step, s, (to_chunks(q), to_chunks(k), to_chunks(v)))
    o = o.swapaxes(0, 1).reshape(B, L - N_META, RET_HEADS, RET_DV)
    return jnp.concatenate([o_meta, o], axis=1), s


def sink_softmax(logits, mask, sink):
    logits = jnp.where(mask, logits, NEG_INF)
    m = jnp.maximum(logits.max(-1, keepdims=True), sink)
    p = jnp.exp(logits - m)
    return p / (p.sum(-1, keepdims=True) + jnp.exp(sink - m))


def swa_prompt(q, k, v, sinks):
    B, L = q.shape[:2]
    nb = -(-L // WINDOW)
    Lp = nb * WINDOW
    pad_end = Lp - L
    qb = jnp.pad(q, ((0, 0), (0, pad_end), (0, 0), (0, 0))).reshape(
        B, nb, WINDOW, SWA_KV_HEADS, SWA_GROUP, SWA_HD)

    def band(a):
        ap = jnp.pad(a, ((0, 0), (WINDOW, pad_end), (0, 0), (0, 0)))
        prev = ap[:, :Lp].reshape(B, nb, WINDOW, SWA_KV_HEADS, SWA_HD)
        cur = ap[:, WINDOW:].reshape(B, nb, WINDOW, SWA_KV_HEADS, SWA_HD)
        return jnp.concatenate([prev, cur], axis=2)

    kb, vb = band(k), band(v)
    blk = jnp.arange(nb)[:, None] * WINDOW
    qpos = blk + jnp.arange(WINDOW)[None]
    kpos = blk - WINDOW + jnp.arange(2 * WINDOW)[None]
    diff = qpos[:, :, None] - kpos[:, None, :]
    mask = (diff >= 0) & (diff < WINDOW) & (kpos[:, None, :] >= 0)
    logits = jnp.einsum('bnqgrd,bnkgd->bngrqk', qb.astype(jnp.float32),
                        kb.astype(jnp.float32)) * (SWA_HD ** -0.5)
    sink = sinks.astype(jnp.float32).reshape(SWA_KV_HEADS, SWA_GROUP)[None, None, :, :, None, None]
    probs = sink_softmax(logits, mask[None, :, None, None], sink)
    o = jnp.einsum('bngrqk,bnkgd->bnqgrd', probs, vb.astype(jnp.float32))
    return o.reshape(B, Lp, SWA_HEADS * SWA_HD)[:, :L].astype(v.dtype)


def swa_sample(q, k_new, v_new, k_buf, v_buf, sinks):
    B, T = q.shape[:2]
    kk = jnp.concatenate([k_buf.astype(k_new.dtype), k_new], axis=1)
    vv = jnp.concatenate([v_buf.astype(v_new.dtype), v_new], axis=1)
    qpos = BUF_LEN + jnp.arange(T)
    kpos = jnp.arange(BUF_LEN + T)
    diff = qpos[:, None] - kpos[None, :]
    mask = (diff >= 0) & (diff < WINDOW)
    qg = q.reshape(B, T, SWA_KV_HEADS, SWA_GROUP, SWA_HD).astype(jnp.float32)
    logits = jnp.einsum('btgrd,bkgd->bgrtk', qg, kk.astype(jnp.float32)) * (SWA_HD ** -0.5)
    sink = sinks.astype(jnp.float32).reshape(SWA_KV_HEADS, SWA_GROUP)[None, :, :, None, None]
    probs = sink_softmax(logits, mask[None, None, None], sink)
    o = jnp.einsum('bgrtk,bkgd->btgrd', probs, vv.astype(jnp.float32))
    return (o.reshape(B, T, SWA_HEADS * SWA_HD).astype(v_new.dtype),
            kk[:, -BUF_LEN:], vv[:, -BUF_LEN:])


def layer_tail(x, ret_o, ret_gate, swa_o, w_out, ln_mix_g, ln_mix_b,
               w_ffn_gate, w_ffn_up, w_ffn_down, ln_ffn_g, ln_ffn_b):
    B, T, _ = x.shape
    ret_o = head_group_norm(ret_o).astype(x.dtype) * jax.nn.silu(ret_gate)
    mixed = jnp.concatenate([ret_o.reshape(B, T, -1), swa_o.reshape(B, T, -1)], axis=-1)
    h = layer_norm(ALPHA * x + mixed @ w_out, ln_mix_g, ln_mix_b)
    f = (jax.nn.silu(h @ w_ffn_gate) * (h @ w_ffn_up)) @ w_ffn_down
    return layer_norm(ALPHA * h + f, ln_ffn_g, ln_ffn_b)


def setup_inputs(seed: int = 0) -> dict:
    key = jax.random.key(seed)
    ks = jax.random.split(key, 20)
    f32 = jnp.float32
    nrm = lambda k, shape, s: jax.random.normal(k, shape, f32) * s
    return {
        "x_prompt": nrm(ks[0], (BATCH, SEQ, D_MODEL), 1.0),
        "x_sample": nrm(ks[1], (DEC_BATCH, DEC_SEQ, D_MODEL), 1.0),
        "state_ret": nrm(ks[2], (DEPTH, DEC_BATCH, RET_HEADS, RET_DK, RET_DV), 0.5),
        "cache_swa_k": nrm(ks[3], (DEPTH, DEC_BATCH, BUF_LEN, SWA_KV_HEADS, SWA_HD), 1.0),
        "cache_swa_v": nrm(ks[4], (DEPTH, DEC_BATCH, BUF_LEN, SWA_KV_HEADS, SWA_HD), 1.0),
        "meta_tokens": nrm(ks[5], (N_META, D_MODEL), 1.0),
        "ln_emb_g": 1.0 + nrm(ks[6], (D_MODEL,), 0.02),
        "ln_emb_b": nrm(ks[7], (D_MODEL,), 0.02),
        "w_in": nrm(ks[8], (DEPTH, D_MODEL, PROJ_W), D_MODEL ** -0.5),
        "w_out": nrm(ks[9], (DEPTH, MIX_W, D_MODEL), BETA * MIX_W ** -0.5),
        "swa_sinks": nrm(ks[10], (DEPTH, SWA_HEADS), 0.5),
        "ln_mix_g": 1.0 + nrm(ks[11], (DEPTH, D_MODEL), 0.02),
        "ln_mix_b": nrm(ks[12], (DEPTH, D_MODEL), 0.02),
        "w_ffn_gate": nrm(ks[13], (DEPTH, D_MODEL, FFN_HIDDEN), D_MODEL ** -0.5),
        "w_ffn_up": nrm(ks[14], (DEPTH, D_MODEL, FFN_HIDDEN), D_MODEL ** -0.5),
        "w_ffn_down": nrm(ks[15], (DEPTH, FFN_HIDDEN, D_MODEL), BETA * FFN_HIDDEN ** -0.5),
        "ln_ffn_g": 1.0 + nrm(ks[16], (DEPTH, D_MODEL), 0.02),
        "ln_ffn_b": nrm(ks[17], (DEPTH, D_MODEL), 0.02),
    }


def reference(x_prompt, x_sample, state_ret, cache_swa_k, cache_swa_v, meta_tokens,
              ln_emb_g, ln_emb_b, w_in, w_out, swa_sinks, ln_mix_g, ln_mix_b,
              w_ffn_gate, w_ffn_up, w_ffn_down, ln_ffn_g, ln_ffn_b):
    B, S, D = x_prompt.shape
    T = x_sample.shape[1]
    log_gamma = retention_log_gamma()
    meta = jnp.broadcast_to(meta_tokens.astype(x_prompt.dtype)[None], (B, N_META, D))
    h_p = layer_norm(jnp.concatenate([meta, x_prompt], axis=1), ln_emb_g, ln_emb_b)
    h_s = layer_norm(x_sample, ln_emb_g, ln_emb_b)
    pos_p = jnp.arange(N_META + S)
    pos_s = PAST_LEN + jnp.arange(T)
    ret_p, k_p, v_p, ret_s, k_s, v_s = [], [], [], [], [], []
    for l in range(DEPTH):
        rq, rk, rv, rg, sq, sk, sv = mixer_projections(h_p, pos_p, w_in[l])
        ret_o, s_new = retention_prompt(rq, rk, rv, log_gamma)
        swa_o = swa_prompt(sq, sk, sv, swa_sinks[l])
        ret_p.append(s_new.astype(h_p.dtype))
        k_p.append(sk[:, -BUF_LEN:])
        v_p.append(sv[:, -BUF_LEN:])
        h_p = layer_tail(h_p, ret_o, rg, swa_o, w_out[l], ln_mix_g[l], ln_mix_b[l],
                         w_ffn_gate[l], w_ffn_up[l], w_ffn_down[l], ln_ffn_g[l], ln_ffn_b[l])
        rq, rk, rv, rg, sq, sk, sv = mixer_projections(h_s, pos_s, w_in[l])
        ret_o, s_new = retention_chunk(rq, rk, rv, state_ret[l], log_gamma)
        swa_o, kb_new, vb_new = swa_sample(sq, sk, sv, cache_swa_k[l], cache_swa_v[l], swa_sinks[l])
        ret_s.append(s_new.astype(h_s.dtype))
        k_s.append(kb_new)
        v_s.append(vb_new)
        h_s = layer_tail(h_s, ret_o, rg, swa_o, w_out[l], ln_mix_g[l], ln_mix_b[l],
                         w_ffn_gate[l], w_ffn_up[l], w_ffn_down[l], ln_ffn_g[l], ln_ffn_b[l])
    y_prompt = h_p[:, N_META:]
    y_sample = h_s
    return (y_prompt, y_sample, jnp.stack(ret_p), jnp.stack(k_p), jnp.stack(v_p),
            jnp.stack(ret_s), jnp.stack(k_s), jnp.stack(v_s))
```

```cpp
#include <hip/hip_runtime.h>
#include <hip/hip_cooperative_groups.h>
#include <cstdio>
namespace cg = cooperative_groups;

#ifndef N_LAUNCH_MODE
#define N_LAUNCH_MODE 0
#endif

#ifndef REP0
#define REP0 1
#endif
#ifndef REPMIX
#define REPMIX 1
#endif
#ifndef REPLN
#define REPLN 1
#endif
#ifndef REPG
#define REPG 0
#endif
#ifndef REPSYNC
#define REPSYNC 1
#endif
#define LAS __attribute__((address_space(3)))
typedef unsigned short bf16_t;
typedef short bf16x8 __attribute__((ext_vector_type(8)));
typedef float f32x4 __attribute__((ext_vector_type(4)));
typedef unsigned u32x4 __attribute__((ext_vector_type(4)));
typedef unsigned u32x2 __attribute__((ext_vector_type(2)));

constexpr int D = 2048, LP = 2064, MS = 1024, M = 9280, MPAD = 9472, PW = 5376, FF = 5632;
constexpr int SROW = 8192, MR = 9216, METAROW = 9216;
constexpr int ZQ = 0, ZK = 1024, ZV = 2048, ZG = 3072, ZSQ = 4096, ZSK = 5120, ZSV = 5248;
constexpr int NPOS = 2072;
constexpr float ALPHA = 1.189207115002721f, LN_EPS = 1e-5f;
constexpr size_t OFF_YP = 0, OFF_YS = 16777216, OFF_RSP = 18874368, OFF_KP = 19922944, OFF_VP = 19988480,
                 OFF_RSS = 20054016, OFF_KS = 53608448, OFF_VS = 55705600;
constexpr size_t WS_WIN = 0;
constexpr size_t WS_WO = WS_WIN + (size_t)PW * D * 2;
constexpr size_t WS_WGU = WS_WO + (size_t)D * D * 2;
constexpr size_t WS_MIX = WS_WGU + (size_t)2 * FF * D * 2;
constexpr size_t WS_WD = WS_MIX + (size_t)MPAD * D * 2;
constexpr size_t WS_H = WS_WD + (size_t)D * FF * 2;
constexpr size_t WS_PRE = WS_H + (size_t)MPAD * D * 2;
constexpr size_t WS_Z = WS_PRE + (size_t)MPAD * D * 4;
constexpr size_t WS_U = WS_Z + (size_t)MPAD * PW * 2;
constexpr size_t WS_SB = WS_U + (size_t)272 * 65536 * 4;
constexpr size_t WS_TAB = WS_SB + (size_t)256 * 65536 * 2;
constexpr size_t WS_BAR = WS_TAB + (((size_t)NPOS * 128 * 4 * 2 + (size_t)NPOS * 8 * 4 * 2 + 255) / 256) * 256;
constexpr size_t WS_SKV = WS_BAR + 16384;
constexpr size_t WS_END = WS_SKV + (size_t)512 * 2 * 8 * 256 * 2;
constexpr size_t WS_A2 = WS_Z;
constexpr size_t WS_PRE2 = WS_MIX;
static_assert((size_t)MPAD * D * 2 <= WS_WD - WS_MIX, "PRE2 alias");
static_assert((size_t)MPAD * FF * 2 <= WS_SB - WS_Z, "A2 alias");
constexpr int LDS_BYTES = 147456, LDS_CTL = 147440;

__device__ __forceinline__ float lg2gamma(int h) {
    return h == 0 ? -0.04580368961312479f : h == 1 ? -0.02272007650008353f : h == 2 ? -0.011315313227834146f : -0.005646563141142063f;
}
__device__ __forceinline__ int prow(int b, int t) { return t < 16 ? METAROW + b * 16 + t : b * 2048 + (t - 16); }
__device__ __forceinline__ float fexp2(float x) { return __builtin_amdgcn_exp2f(x); }
__device__ __forceinline__ float fexp(float x) { return __builtin_amdgcn_exp2f(x * 1.4426950408889634f); }
__device__ __forceinline__ float bf2f(unsigned b) { return __uint_as_float(b << 16); }
__device__ __forceinline__ unsigned cvt_pk_bf16(float lo, float hi) { unsigned r; asm volatile("v_cvt_pk_bf16_f32 %0, %1, %2" : "=v"(r) : "v"(lo), "v"(hi)); return r; }
__device__ __forceinline__ bf16_t f2bf(float f) { return (bf16_t)(cvt_pk_bf16(f, 0.f) & 0xffffu); }
__device__ __forceinline__ float silu(float x) { return x * __builtin_amdgcn_rcpf(1.f + fexp(-x)); }
__device__ __forceinline__ f32x4 ld4(const float* p, int i) { return ((const f32x4*)p)[i]; }
__device__ __forceinline__ f32x4 ld4(const bf16_t* p, int i) { const u32x2 r = ((const u32x2*)p)[i]; return (f32x4){bf2f(r.x & 0xffffu), bf2f(r.x >> 16), bf2f(r.y & 0xffffu), bf2f(r.y >> 16)}; }
__device__ __forceinline__ void unpack8(const u32x4 r, f32x4& lo, f32x4& hi) {
    lo = (f32x4){bf2f(r.x & 0xffffu), bf2f(r.x >> 16), bf2f(r.y & 0xffffu), bf2f(r.y >> 16)};
    hi = (f32x4){bf2f(r.z & 0xffffu), bf2f(r.z >> 16), bf2f(r.w & 0xffffu), bf2f(r.w >> 16)};
}
__device__ __forceinline__ float wave_sum(float v) {
#pragma unroll
    for (int o = 1; o < 64; o <<= 1) v += __shfl_xor(v, o);
    return v;
}
__device__ __forceinline__ f32x4 mfma16(bf16x8 a, bf16x8 b, f32x4 c) { return __builtin_amdgcn_mfma_f32_16x16x32_bf16(a, b, c, 0, 0, 0); }
__device__ __forceinline__ bf16x8 as_bf16x8(u32x4 v) { union { u32x4 u; bf16x8 b; } x; x.u = v; return x.b; }

struct Args { const float* in[18]; float* out; unsigned char* ws; int ph_lo, ph_hi; };
typedef const __attribute__((address_space(4))) Args* KArgs;
__device__ __forceinline__ KArgs kargs() { KArgs p = (KArgs)__builtin_amdgcn_kernarg_segment_ptr(); asm volatile("" : "+s"(p)); return p; }
__device__ __forceinline__ int ltid() { int t = threadIdx.x; asm volatile("" : "+v"(t)); return t; }


#define XB_TMO      128
#define XB_XCNT(j)  (256  + 64 * (j))
#define XB_XSUB(j)  (1280 + 64 * (j))
#define XB_XGEN(j)  (2304 + 64 * (j))
#define XB_TOP      3328
#define XB_TOPGEN   3392
#define XCD_BAR_WORDS 3456
#define XB_SPIN_CAP (1u << 18)
__device__ __forceinline__ unsigned xb_ld(unsigned* p)              { return __hip_atomic_load(p, __ATOMIC_RELAXED, __HIP_MEMORY_SCOPE_AGENT); }
__device__ __forceinline__ unsigned xb_add(unsigned* p, unsigned v) { return __hip_atomic_fetch_add(p, v, __ATOMIC_RELAXED, __HIP_MEMORY_SCOPE_AGENT); }
__device__ __forceinline__ unsigned xb_xcc_id() { return (unsigned)__builtin_amdgcn_s_getreg((3 << 11) | 20) & 0xFu; }
#define XB_SPIN(cond, bar) do { unsigned _sp = 0; while (cond) { __builtin_amdgcn_s_sleep(1); \
    if ((++_sp & 255u) == 0u) { if (xb_ld(&(bar)[XB_TMO])) break; if (_sp > XB_SPIN_CAP) { atomicAdd(&(bar)[XB_TMO], 1u); break; } } } } while (0)
__device__ __forceinline__ void xcd_barrier_complete(unsigned* bar, unsigned x, unsigned& nloc, unsigned& nx) {
    const unsigned G = gridDim.x * gridDim.y * gridDim.z;
    unsigned sum, cnt, mine, sp = 0u;
    for (;;) {
        sum = 0u; cnt = 0u; mine = 0u;
#pragma unroll
        for (unsigned j = 0; j < 16; ++j) { const unsigned c = xb_ld(&bar[XB_XCNT(j)]); sum += c; cnt += (c > 0u) ? 1u : 0u; mine = (j == x) ? c : mine; }
        if (sum == G) break;
        __builtin_amdgcn_s_sleep(1);
        if ((++sp & 255u) == 0u) { if (xb_ld(&bar[XB_TMO])) break; if (sp > XB_SPIN_CAP) { atomicAdd(&bar[XB_TMO], 1u); break; } }
    }
    nloc = mine > 0u ? mine : 1u; nx = cnt > 0u ? cnt : 1u;
}
__device__ __forceinline__ void xcd_barrier(unsigned* bar, volatile LAS unsigned* st) {
    asm volatile("s_waitcnt vmcnt(0)" ::: "memory");
    __syncthreads();
    if (threadIdx.x == 0) {
        const unsigned x = xb_xcc_id();
        __builtin_amdgcn_s_waitcnt(0);
        unsigned nloc = st[0], nx = st[1];
        if (nloc == 0u) { xcd_barrier_complete(bar, x, nloc, nx); st[0] = nloc; st[1] = nx; }
        const unsigned old = xb_add(&bar[XB_XSUB(x)], 1u);
        const unsigned gen = old / nloc;
        if (old + 1u == (gen + 1u) * nloc) {
            __builtin_amdgcn_fence(__ATOMIC_RELEASE, "agent");
            asm volatile("s_waitcnt vmcnt(0)" ::: "memory");
            const unsigned og = xb_add(&bar[XB_TOP], 1u);
            const unsigned tg = og / nx;
            if (og + 1u == (tg + 1u) * nx) xb_add(&bar[XB_TOPGEN], 1u);
            else XB_SPIN(xb_ld(&bar[XB_TOPGEN]) == tg, bar);
            __builtin_amdgcn_fence(__ATOMIC_ACQUIRE, "agent");
            xb_add(&bar[XB_XGEN(x)], 1u);
            asm volatile("s_waitcnt vmcnt(0)" ::: "memory");
        } else {
            XB_SPIN(xb_ld(&bar[XB_XGEN(x)]) == gen, bar);
            __builtin_amdgcn_fence(__ATOMIC_ACQUIRE, "agent");
            asm volatile("s_waitcnt vmcnt(0)" ::: "memory");
        }
    }
    __syncthreads();
}

namespace pg8 {
constexpr int BM = 256, BK = 64, HALF = 128, HTB = HALF * BK * 2, STAGE_BYTES = 8 * HTB, NXCD = 8, WGM = 4;
__device__ __forceinline__ int lds_byte(int r, int c) { const int st = (r >> 4) * 2 + (c >> 5), rr = r & 15, cc = c & 31, ob = rr * 64 + cc * 2; return st * 1024 + (ob ^ (((ob >> 9) & 1) << 5)); }
__device__ __forceinline__ void stage_rc(int b, int& R, int& C) { const int st = b / 1024, sb = b % 1024, swz = sb ^ (((sb >> 9) & 1) << 5); R = (st >> 1) * 16 + swz / 64; C = (st & 1) * 32 + (swz % 64) / 2; }
__device__ __forceinline__ int perm32(int rho) { const int n = rho >> 4, i = rho & 15; return 8 * (i >> 2) + 4 * n + (i & 3); }
struct Unit { int pm, pn; };
struct Gemm { const bf16_t* A; const bf16_t* Bt; int ld, K, nNr; size_t ksb; };
struct StaticOrder {
    int nM, nN, nwg, G, c, nextra;
    int i0, ilim;
    int tailM;
    int pm0;
    __device__ __forceinline__ void init(int M_, int N_, int G_, int c_, int nextra_ = 0) { nM = M_ / BM; nN = N_ / BM; nwg = nM * nN; G = G_; c = c_; nextra = nextra_; i0 = 0; ilim = 1 << 20; tailM = 0; pm0 = 0; }
    __device__ __forceinline__ int total() const { return nwg + nextra + tailM * nN; }
    __device__ __forceinline__ void tile(int wgid, int& pm, int& pn) const {
        { const int q = nwg / NXCD, r = nwg % NXCD, xcd = wgid % NXCD, off = wgid / NXCD; wgid = (xcd < r ? xcd * (q + 1) : r * (q + 1) + (xcd - r) * q) + off; }
        const int nig = WGM * nN, gid = wgid / nig, fm = gid * WGM, gsz = (nM - fm) < WGM ? (nM - fm) : WGM;
        pm = fm + ((wgid % nig) % gsz); pn = (wgid % nig) / gsz;
    }
    __device__ __forceinline__ bool next(int i, Unit& u) const {
        const int ii = i + i0; if (ii >= ilim) return false;
        const long L = (long)ii * G + c; if (L >= total()) return false;
        if (L >= nwg && tailM > 0) { const int x = (int)L - nwg; u.pm = pm0 + nM + x % tailM; u.pn = x / tailM; return true; }
        if (L >= nwg) { const int x = (int)L - nwg; u.pm = nM; u.pn = x < 8 ? 4 + x : 20; return true; }
        tile((int)L, u.pm, u.pn); u.pm += pm0; return true;
    }
};

template <class Epi>
__device__ __forceinline__ void gemm_phase(LAS unsigned char* lds, const Gemm g, const StaticOrder& S, const Epi& E) {
    const int tid = ltid(), wid = __builtin_amdgcn_readfirstlane(tid >> 6), lane = tid & 63, wr = wid >> 2, wc = wid & 3, fr = lane & 15, fq = lane >> 4;
    const int K = g.K, nt = K / BK;
    const int ld = g.ld;
    unsigned voffA[2], voffB[2];
#pragma unroll
    for (int i = 0; i < 2; ++i) { int R, C; stage_rc(tid * 16 + i * 8192, R, C); const int Rb = Epi::PERM ? ((R & ~31) + perm32(R & 31)) : R;
        voffA[i] = (unsigned)(R * ld + C) * 2u; voffB[i] = (unsigned)(Rb * ld + C) * 2u; }
    const size_t kstep = (size_t)(BK * 2);
    const size_t hstep = (size_t)HALF * ld * 2;
    const size_t tstep = 2 * hstep;
    const unsigned ldsw = (unsigned)wid * 1024u;
    const int aoff = lds_byte(wr * 64 + fr, fq * 8), boff = lds_byte(wc * 32 + fr, fq * 8);
#define PG8_SA(b, h) (((b) * 2 + (h)) * HTB)
#define PG8_SB(b, h) ((4 + (b) * 2 + (h)) * HTB)
#define PG8_STAGE(bufoff, gbase, voff) do { _Pragma("unroll") for (int _i = 0; _i < 2; ++_i) \
        __builtin_amdgcn_global_load_lds((const unsigned*)((const char*)(gbase) + (voff)[_i]), (LAS unsigned*)(lds + (bufoff) + ldsw + _i * 8192), 16, 0, 0); } while (0)
#define PG8_LDA(dst, b, h) do { _Pragma("unroll") for (int m = 0; m < 4; ++m) _Pragma("unroll") for (int k = 0; k < 2; ++k) dst[m][k] = *(const LAS bf16x8*)(lds + PG8_SA(b, h) + aoff + m * 2048 + k * 1024); } while (0)
#define PG8_LDB(dst, b, h) do { _Pragma("unroll") for (int n = 0; n < 2; ++n) _Pragma("unroll") for (int k = 0; k < 2; ++k) dst[n][k] = *(const LAS bf16x8*)(lds + PG8_SB(b, h) + boff + n * 2048 + k * 1024); } while (0)
#define PG8_MMA(ai, bj, At, Bt) do { __builtin_amdgcn_s_setprio(1); _Pragma("unroll") for (int m = 0; m < 4; ++m) _Pragma("unroll") for (int n = 0; n < 2; ++n) _Pragma("unroll") for (int k = 0; k < 2; ++k) \
        acc[ai][bj][m][n] = __builtin_amdgcn_mfma_f32_16x16x32_bf16(Bt[n][k], At[m][k], acc[ai][bj][m][n], 0, 0, 0); __builtin_amdgcn_s_setprio(0); } while (0)
#define PG8_WAIT_V(n) asm volatile("s_waitcnt vmcnt(" #n ")" ::: "memory")
#define PG8_WAIT_L(n) asm volatile("s_waitcnt lgkmcnt(" #n ")" ::: "memory")
#define PG8_BAR __builtin_amdgcn_s_barrier()
#define PG8_SCHED __builtin_amdgcn_sched_barrier(0)
    Unit cur, nxt; int ui = 0;
    if (!S.next(0, cur)) return;
    f32x4 acc[2][2][4][2];
#pragma unroll
    for (int a = 0; a < 2; ++a)
#pragma unroll
        for (int b = 0; b < 2; ++b)
#pragma unroll
            for (int m = 0; m < 4; ++m)
#pragma unroll
                for (int n = 0; n < 2; ++n) acc[a][b][m][n] = (f32x4){0.f, 0.f, 0.f, 0.f};
    bf16x8 At[4][2], B0[2][2], B1[2][2];
#define PG8_APTR(u) ((const char*)g.A + (size_t)(u).pm * tstep + (size_t)((u).pn / g.nNr) * g.ksb)
#define PG8_BPTR(u) ((const char*)g.Bt + (size_t)((u).pn % g.nNr) * tstep + (size_t)((u).pn / g.nNr) * g.ksb)
    const char* cA = PG8_APTR(cur); const char* cB = PG8_BPTR(cur);
    PG8_STAGE(PG8_SB(0, 0), cB, voffB); PG8_STAGE(PG8_SA(0, 0), cA, voffA); PG8_STAGE(PG8_SB(0, 1), cB + hstep, voffB); PG8_STAGE(PG8_SA(0, 1), cA + hstep, voffA);
    if (wr == 1) PG8_BAR;
    PG8_WAIT_V(4); PG8_BAR;
    PG8_STAGE(PG8_SB(1, 0), cB + kstep, voffB); PG8_STAGE(PG8_SA(1, 0), cA + kstep, voffA); PG8_STAGE(PG8_SB(1, 1), cB + hstep + kstep, voffB);
    PG8_WAIT_V(6); PG8_BAR;
    for (;;) {
        const bool has_next = S.next(ui + 1, nxt);
        const char* nA = has_next ? PG8_APTR(nxt) : cA; const char* nB = has_next ? PG8_BPTR(nxt) : cB;
        for (int t = 0; t < nt; t += 2) {
            const bool last = (t == nt - 2);
            const char* a1 = cA + (size_t)(t + 1) * kstep;
            const char* a2 = last ? nA : cA + (size_t)(t + 2) * kstep; const char* b2 = last ? nB : cB + (size_t)(t + 2) * kstep;
            const char* a3 = a2 + kstep; const char* b3 = b2 + kstep;
            PG8_LDB(B0, 0, 0); PG8_SCHED; PG8_LDA(At, 0, 0); PG8_STAGE(PG8_SA(1, 1), a1 + hstep, voffA);
            PG8_WAIT_L(8); PG8_BAR; PG8_WAIT_L(0); PG8_MMA(0, 0, At, B0); PG8_BAR; PG8_SCHED;
            PG8_LDB(B1, 0, 1); PG8_STAGE(PG8_SB(0, 0), b2, voffB);
            PG8_BAR; PG8_WAIT_L(0); PG8_MMA(0, 1, At, B1); PG8_BAR;
            PG8_LDA(At, 0, 1); PG8_STAGE(PG8_SA(0, 0), a2, voffA);
            PG8_BAR; PG8_WAIT_L(0); PG8_MMA(1, 0, At, B0); PG8_BAR; PG8_SCHED;
            PG8_STAGE(PG8_SB(0, 1), b2 + hstep, voffB);
            PG8_WAIT_V(6); PG8_BAR; PG8_MMA(1, 1, At, B1); PG8_BAR;
            PG8_LDB(B0, 1, 0); PG8_SCHED; PG8_LDA(At, 1, 0); PG8_STAGE(PG8_SA(0, 1), a2 + hstep, voffA);
            PG8_WAIT_L(8); PG8_BAR; PG8_WAIT_L(0); PG8_MMA(0, 0, At, B0); PG8_BAR; PG8_SCHED;
            PG8_LDB(B1, 1, 1); PG8_STAGE(PG8_SB(1, 0), b3, voffB);
            PG8_BAR; PG8_WAIT_L(0); PG8_MMA(0, 1, At, B1); PG8_BAR;
            PG8_LDA(At, 1, 1); PG8_STAGE(PG8_SA(1, 0), a3, voffA);
            PG8_BAR; PG8_WAIT_L(0); PG8_MMA(1, 0, At, B0); PG8_BAR; PG8_SCHED;
            PG8_STAGE(PG8_SB(1, 1), b3 + hstep, voffB);
            PG8_WAIT_V(6); PG8_BAR; PG8_MMA(1, 1, At, B1); PG8_BAR;
        }
        E(acc, cur, wr, wc, fr, fq);
        if (!has_next) break;
#pragma unroll
        for (int a = 0; a < 2; ++a)
#pragma unroll
            for (int b = 0; b < 2; ++b)
#pragma unroll
                for (int m = 0; m < 4; ++m)
#pragma unroll
                    for (int n = 0; n < 2; ++n) acc[a][b][m][n] = (f32x4){0.f, 0.f, 0.f, 0.f};
        cur = nxt; cA = nA; cB = nB; ++ui;
    }
    PG8_WAIT_V(0);
    if (wr == 0) PG8_BAR;
    PG8_BAR;
#undef PG8_APTR
#undef PG8_BPTR
#undef PG8_SA
#undef PG8_SB
#undef PG8_STAGE
#undef PG8_LDA
#undef PG8_LDB
#undef PG8_MMA
#undef PG8_WAIT_V
#undef PG8_WAIT_L
#undef PG8_BAR
#undef PG8_SCHED
}
}

struct EpiIn {
    static constexpr bool PERM = true;
    bf16_t* Z; const float* cosR; const float* sinR; const float* cosS; const float* sinS; float* out;
    __device__ __forceinline__ void operator()(const f32x4 (&acc)[2][2][4][2], const pg8::Unit& u, int wr, int wc, int fr, int fq) const {
        const int pn = u.pn;
#pragma unroll
        for (int ai = 0; ai < 2; ++ai) {
            f32x4 tc0[4], tc1[4], ts0[4], ts1[4];
            if (pn < 8 || pn >= 16) {
#pragma unroll
                for (int m = 0; m < 4; ++m) {
                    const int row = u.pm * 256 + ai * 128 + wr * 64 + m * 16 + fr; int tab = 0;
                    if (row < SROW) tab = 16 + (row & 2047); else if (row < MR) tab = LP + ((row - SROW) & 7); else if (row < M) tab = (row - METAROW) & 15;
                    const float* cp_ = pn < 8 ? cosR + tab * 128 + wc * 32 + 8 * fq : cosS + tab * 8;
                    const float* sp_ = pn < 8 ? sinR + tab * 128 + wc * 32 + 8 * fq : sinS + tab * 8;
                    tc0[m] = *(const f32x4*)cp_; tc1[m] = *(const f32x4*)(cp_ + 4); ts0[m] = *(const f32x4*)sp_; ts1[m] = *(const f32x4*)(sp_ + 4);
                }
            }
#pragma unroll
            for (int m = 0; m < 4; ++m) {
                const int row = u.pm * 256 + ai * 128 + wr * 64 + m * 16 + fr;
                int b = 0, t = 0, tab = 0; const bool isP = row < SROW || (row >= METAROW && row < M), isS = (row >= SROW) && (row < MR);
                if (row < SROW) { b = row >> 11; t = 16 + (row & 2047); tab = t; } else if (isS) { const int s = row - SROW; b = s >> 3; t = s & 7; tab = LP + t; }
                else if (isP) { const int mrow = row - METAROW; b = mrow >> 4; t = mrow & 15; tab = t; }
                f32x4 o00 = acc[ai][0][m][0], o01 = acc[ai][0][m][1], o10 = acc[ai][1][m][0], o11 = acc[ai][1][m][1];
                if (pn < 8) {
                    const f32x4 c0 = tc0[m], c1 = tc1[m], s0 = ts0[m], s1 = ts1[m];
                    const float sc = pn >= 4 ? 0.0625f : 1.0f;
                    const f32x4 a0 = o00, a1 = o01, b0 = o10, b1 = o11;
                    o00 = (a0 * c0 - b0 * s0) * sc; o10 = (b0 * c0 + a0 * s0) * sc;
                    o01 = (a1 * c1 - b1 * s1) * sc; o11 = (b1 * c1 + a1 * s1) * sc;
                } else if (pn < 12) {
                } else if (pn < 16) {
#pragma unroll
                    for (int j = 0; j < 4; ++j) { o00[j] = silu(o00[j]); o01[j] = silu(o01[j]); o10[j] = silu(o10[j]); o11[j] = silu(o11[j]); }
                } else {
                    const f32x4 c0 = tc0[m], c1 = tc1[m], s0 = ts0[m], s1 = ts1[m];
                    const bool rot = ((wc & 1) == 0) && (fq < 2); const float sg = fq == 0 ? -1.f : 1.f;
                    f32x4 p;
#pragma unroll
                    for (int j = 0; j < 4; ++j) p[j] = __shfl_xor(o00[j], 16);
                    if (rot) o00 = o00 * c0 + p * s0 * sg;
#pragma unroll
                    for (int j = 0; j < 4; ++j) p[j] = __shfl_xor(o01[j], 16);
                    if (rot) o01 = o01 * c1 + p * s1 * sg;
                    if (pn < 20) {
#pragma unroll
                        for (int j = 0; j < 4; ++j) p[j] = __shfl_xor(o10[j], 16);
                        if (rot) o10 = o10 * c0 + p * s0 * sg;
#pragma unroll
                        for (int j = 0; j < 4; ++j) p[j] = __shfl_xor(o11[j], 16);
                        if (rot) o11 = o11 * c1 + p * s1 * sg;
                        o00 *= 0.125f; o01 *= 0.125f; o10 *= 0.125f; o11 *= 0.125f;
                    } else {
                        const int cc = wc * 32 + 8 * fq;
                        if (isP && t >= LP - 128) {
                            float* kp = out + OFF_KP + ((size_t)(b * 128 + (t - (LP - 128))) * 128 + cc);
                            float* vp = out + OFF_VP + ((size_t)(b * 128 + (t - (LP - 128))) * 128 + cc);
                            *(f32x4*)kp = o00; *(f32x4*)(kp + 4) = o01; *(f32x4*)vp = o10; *(f32x4*)(vp + 4) = o11;
                        } else if (isS) {
                            float* kp = out + OFF_KS + ((size_t)(b * 128 + 120 + t) * 128 + cc);
                            float* vp = out + OFF_VS + ((size_t)(b * 128 + 120 + t) * 128 + cc);
                            *(f32x4*)kp = o00; *(f32x4*)(kp + 4) = o01; *(f32x4*)vp = o10; *(f32x4*)(vp + 4) = o11;
                        }
                    }
                }
                bf16_t* zrow = Z + (size_t)row * PW + pn * 256 + wc * 32 + 8 * fq;
                u32x4 w0, w1;
                w0.x = cvt_pk_bf16(o00[0], o00[1]); w0.y = cvt_pk_bf16(o00[2], o00[3]); w0.z = cvt_pk_bf16(o01[0], o01[1]); w0.w = cvt_pk_bf16(o01[2], o01[3]);
                w1.x = cvt_pk_bf16(o10[0], o10[1]); w1.y = cvt_pk_bf16(o10[2], o10[3]); w1.z = cvt_pk_bf16(o11[0], o11[1]); w1.w = cvt_pk_bf16(o11[2], o11[3]);
                *(u32x4*)zrow = w0; *(u32x4*)(zrow + 128) = w1;
            }
        }
    }
};
struct EpiRes {
    static constexpr bool PERM = true;
    bf16_t* PRE; const bf16_t* R; bf16_t* PRE2;
    __device__ __forceinline__ void operator()(const f32x4 (&acc)[2][2][4][2], const pg8::Unit& u, int wr, int wc, int fr, int fq) const {
        const bool second = u.pn >= 8; const int pn = u.pn & 7; bf16_t* dst = second ? PRE2 : PRE;
        u32x4 rr[2][4][2];
        if (!second) {
#pragma unroll
            for (int ai = 0; ai < 2; ++ai)
#pragma unroll
                for (int m = 0; m < 4; ++m)
#pragma unroll
                    for (int bj = 0; bj < 2; ++bj) rr[ai][m][bj] = *(const u32x4*)(R + (size_t)(u.pm * 256 + ai * 128 + wr * 64 + m * 16 + fr) * D + pn * 256 + wc * 32 + 8 * fq + bj * 128);
        }
#pragma unroll
        for (int ai = 0; ai < 2; ++ai)
#pragma unroll
            for (int m = 0; m < 4; ++m) {
                const size_t off = (size_t)(u.pm * 256 + ai * 128 + wr * 64 + m * 16 + fr) * D + pn * 256 + wc * 32 + 8 * fq;
#pragma unroll
                for (int bj = 0; bj < 2; ++bj) {
                    f32x4 o0 = acc[ai][bj][m][0], o1 = acc[ai][bj][m][1];
                    if (!second) {
                        const u32x4 r = rr[ai][m][bj];
                        o0 += (f32x4){bf2f(r.x & 0xffffu), bf2f(r.x >> 16), bf2f(r.y & 0xffffu), bf2f(r.y >> 16)} * ALPHA;
                        o1 += (f32x4){bf2f(r.z & 0xffffu), bf2f(r.z >> 16), bf2f(r.w & 0xffffu), bf2f(r.w >> 16)} * ALPHA;
                    }
                    u32x4 w; w.x = cvt_pk_bf16(o0[0], o0[1]); w.y = cvt_pk_bf16(o0[2], o0[3]); w.z = cvt_pk_bf16(o1[0], o1[1]); w.w = cvt_pk_bf16(o1[2], o1[3]);
                    *(u32x4*)(dst + off + bj * 128) = w;
                }
            }
    }
};
struct EpiGlu {
    static constexpr bool PERM = true;
    bf16_t* A2;
    __device__ __forceinline__ void operator()(const f32x4 (&acc)[2][2][4][2], const pg8::Unit& u, int wr, int wc, int fr, int fq) const {
#pragma unroll
        for (int ai = 0; ai < 2; ++ai)
#pragma unroll
            for (int m = 0; m < 4; ++m) {
                const size_t off = (size_t)(u.pm * 256 + ai * 128 + wr * 64 + m * 16 + fr) * FF + u.pn * 128 + wc * 32 + 8 * fq;
                f32x4 h0, h1;
#pragma unroll
                for (int j = 0; j < 4; ++j) { h0[j] = silu(acc[ai][0][m][0][j]) * acc[ai][1][m][0][j]; h1[j] = silu(acc[ai][0][m][1][j]) * acc[ai][1][m][1][j]; }
                u32x4 w; w.x = cvt_pk_bf16(h0[0], h0[1]); w.y = cvt_pk_bf16(h0[2], h0[3]); w.z = cvt_pk_bf16(h1[0], h1[1]); w.w = cvt_pk_bf16(h1[2], h1[3]);
                *(u32x4*)(A2 + off) = w;
            }
    }
};

struct TrDesc { const float* W; bf16_t* WT; int K, N, k0, n0, drow; };
__device__ __forceinline__ void tr_load(const TrDesc& d, f32x4 (&v)[16], int lane) {
#pragma unroll
    for (int i = 0; i < 16; ++i) { const int kk = 4 * i + (lane >> 4), c4 = lane & 15; v[i] = __builtin_nontemporal_load((const f32x4*)(d.W + (size_t)(d.k0 + kk) * d.N + d.n0 + 4 * c4)); }
}
__device__ __forceinline__ void tr_store(const TrDesc& d, const f32x4 (&v)[16], float* scr, int lane) {
#pragma unroll
    for (int i = 0; i < 16; ++i) {
        const int kk = 4 * i + (lane >> 4), c4 = lane & 15;
        float* s = scr + kk * 65 + 4 * c4; s[0] = v[i][0]; s[1] = v[i][1]; s[2] = v[i][2]; s[3] = v[i][3];
    }
    asm volatile("s_waitcnt lgkmcnt(0)" ::: "memory");
    const int c = lane & 7;
#pragma unroll
    for (int jn = 0; jn < 8; ++jn) {
        const int n = (lane >> 3) + 8 * jn; const float* s = scr + (8 * c) * 65 + n;
        u32x4 o; o.x = cvt_pk_bf16(s[0], s[65]); o.y = cvt_pk_bf16(s[130], s[195]); o.z = cvt_pk_bf16(s[260], s[325]); o.w = cvt_pk_bf16(s[390], s[455]);
        *(u32x4*)(d.WT + (size_t)(d.drow + n) * d.K + d.k0 + 8 * c) = o;
    }
    asm volatile("s_waitcnt lgkmcnt(0)" ::: "memory");
}
template <int SET>
__device__ __forceinline__ TrDesc tr_decode(KArgs a, int it) {
    unsigned char* ws = a->ws; TrDesc d;
    if (SET == 0) {
        if (it < 32 * 84) { const int kb = it / 84, nb = it % 84; d = TrDesc{a->in[8], (bf16_t*)(ws + WS_WIN), D, PW, 64 * kb, 64 * nb, 64 * nb}; }
        else { const int r = it - 32 * 84, kb = r / 32, nb = r % 32; d = TrDesc{a->in[9], (bf16_t*)(ws + WS_WO), D, D, 64 * kb, 64 * nb, 64 * nb}; }
    } else {
        constexpr int I_G = 32 * 88;
        if (it < I_G) { const int kb = it / 88, nb = it % 88, n0 = 64 * nb; d = TrDesc{a->in[13], (bf16_t*)(ws + WS_WGU), D, FF, 64 * kb, n0, 256 * (n0 >> 7) + (n0 & 127)}; }
        else if (it < 2 * I_G) { const int r = it - I_G, kb = r / 88, nb = r % 88, n0 = 64 * nb; d = TrDesc{a->in[14], (bf16_t*)(ws + WS_WGU), D, FF, 64 * kb, n0, 256 * (n0 >> 7) + 128 + (n0 & 127)}; }
        else { const int r = it - 2 * I_G, kb = r / 32, nb = r % 32; d = TrDesc{a->in[15], (bf16_t*)(ws + WS_WD), FF, D, 64 * kb, 64 * nb, 64 * nb}; }
    }
    return d;
}
template <int SET>
__device__ __forceinline__ void transposes(KArgs a, float* scr, int lane, int gw, int NGW) {
    constexpr int NIT = SET == 0 ? 32 * 84 + 32 * 32 : 2 * 32 * 88 + 88 * 32;
    f32x4 va[16], vb[16]; TrDesc d0, d1;
    int it = gw; bool h0 = it < NIT;
    if (h0) { d0 = tr_decode<SET>(a, it); tr_load(d0, va, lane); }
    while (h0) {
        const int it1 = it + NGW; const bool h1 = it1 < NIT;
        if (h1) { d1 = tr_decode<SET>(a, it1); tr_load(d1, vb, lane); }
        tr_store(d0, va, scr, lane);
        if (!h1) break;
        const int it2 = it1 + NGW; const bool h2 = it2 < NIT;
        if (h2) { d0 = tr_decode<SET>(a, it2); tr_load(d0, va, lane); }
        tr_store(d1, vb, scr, lane);
        it = it2; h0 = h2;
    }
}
template <bool OUTF, bool TWO = false, class TI = float>
__device__ __forceinline__ void ln_row(const TI* xrow, const float* g, const float* bta, void* orow, int lane, const TI* xrow2 = nullptr) {
    f32x4 v[8]; float s = 0.f;
#pragma unroll
    for (int j = 0; j < 8; ++j) { v[j] = ld4(xrow, 64 * j + lane); if (TWO) v[j] += ld4(xrow2, 64 * j + lane); s += (v[j][0] + v[j][1]) + (v[j][2] + v[j][3]); }
    const float mean = wave_sum(s) * (1.f / D); float s2 = 0.f;
#pragma unroll
    for (int j = 0; j < 8; ++j) { v[j] = v[j] - mean; s2 += (v[j][0] * v[j][0] + v[j][1] * v[j][1]) + (v[j][2] * v[j][2] + v[j][3] * v[j][3]); }
    const float rstd = 1.f / sqrtf(wave_sum(s2) * (1.f / D) + LN_EPS);
#pragma unroll
    for (int j = 0; j < 8; ++j) {
        const f32x4 gg = ((const f32x4*)g)[64 * j + lane], bb = ((const f32x4*)bta)[64 * j + lane];
        const f32x4 y = v[j] * rstd * gg + bb;
        if (OUTF) ((f32x4*)orow)[64 * j + lane] = y;
        else { u32x2 w; w.x = cvt_pk_bf16(y[0], y[1]); w.y = cvt_pk_bf16(y[2], y[3]); ((u32x2*)orow)[64 * j + lane] = w; }
    }
}
template <bool OUTF>
__device__ __forceinline__ void ln2_bf16(const bf16_t* xa0, const bf16_t* xa1, const bf16_t* xb0, const bf16_t* xb1, bool hasB,
                                         const float* g, const float* bta, void* oa, void* ob, int lane) {
    u32x4 ra0[4], ra1[4], rb0[4], rb1[4]; f32x4 gg[8], bb[8];
#pragma unroll
    for (int j = 0; j < 4; ++j) { ra0[j] = ((const u32x4*)xa0)[64 * j + lane]; ra1[j] = ((const u32x4*)xa1)[64 * j + lane]; rb0[j] = ((const u32x4*)xb0)[64 * j + lane]; rb1[j] = ((const u32x4*)xb1)[64 * j + lane]; }
#pragma unroll
    for (int j = 0; j < 4; ++j) { gg[2 * j] = ((const f32x4*)g)[2 * (64 * j + lane)]; gg[2 * j + 1] = ((const f32x4*)g)[2 * (64 * j + lane) + 1];
                                  bb[2 * j] = ((const f32x4*)bta)[2 * (64 * j + lane)]; bb[2 * j + 1] = ((const f32x4*)bta)[2 * (64 * j + lane) + 1]; }
    f32x4 va[8], vb[8]; float sa = 0.f, sb = 0.f;
#pragma unroll
    for (int j = 0; j < 4; ++j) {
        f32x4 l0, h0, l1, h1;
        unpack8(ra0[j], l0, h0); unpack8(ra1[j], l1, h1); va[2 * j] = l0 + l1; va[2 * j + 1] = h0 + h1;
        unpack8(rb0[j], l0, h0); unpack8(rb1[j], l1, h1); vb[2 * j] = l0 + l1; vb[2 * j + 1] = h0 + h1;
    }
#pragma unroll
    for (int k = 0; k < 8; ++k) { sa += (va[k][0] + va[k][1]) + (va[k][2] + va[k][3]); sb += (vb[k][0] + vb[k][1]) + (vb[k][2] + vb[k][3]); }
    const float ma = wave_sum(sa) * (1.f / D), mb = wave_sum(sb) * (1.f / D); float qa = 0.f, qb = 0.f;
#pragma unroll
    for (int k = 0; k < 8; ++k) { va[k] = va[k] - ma; vb[k] = vb[k] - mb;
        qa += (va[k][0] * va[k][0] + va[k][1] * va[k][1]) + (va[k][2] * va[k][2] + va[k][3] * va[k][3]);
        qb += (vb[k][0] * vb[k][0] + vb[k][1] * vb[k][1]) + (vb[k][2] * vb[k][2] + vb[k][3] * vb[k][3]); }
    const float ra = 1.f / sqrtf(wave_sum(qa) * (1.f / D) + LN_EPS), rb = 1.f / sqrtf(wave_sum(qb) * (1.f / D) + LN_EPS);
#pragma unroll
    for (int j = 0; j < 4; ++j) {
        const f32x4 ya0 = va[2 * j] * ra * gg[2 * j] + bb[2 * j], ya1 = va[2 * j + 1] * ra * gg[2 * j + 1] + bb[2 * j + 1];
        const f32x4 yb0 = vb[2 * j] * rb * gg[2 * j] + bb[2 * j], yb1 = vb[2 * j + 1] * rb * gg[2 * j + 1] + bb[2 * j + 1];
        if (OUTF) {
            ((f32x4*)oa)[2 * (64 * j + lane)] = ya0; ((f32x4*)oa)[2 * (64 * j + lane) + 1] = ya1;
            if (hasB) { ((f32x4*)ob)[2 * (64 * j + lane)] = yb0; ((f32x4*)ob)[2 * (64 * j + lane) + 1] = yb1; }
        } else {
            u32x4 w; w.x = cvt_pk_bf16(ya0[0], ya0[1]); w.y = cvt_pk_bf16(ya0[2], ya0[3]); w.z = cvt_pk_bf16(ya1[0], ya1[1]); w.w = cvt_pk_bf16(ya1[2], ya1[3]);
            ((u32x4*)oa)[64 * j + lane] = w;
            if (hasB) { u32x4 x; x.x = cvt_pk_bf16(yb0[0], yb0[1]); x.y = cvt_pk_bf16(yb0[2], yb0[3]); x.z = cvt_pk_bf16(yb1[0], yb1[1]); x.w = cvt_pk_bf16(yb1[2], yb1[3]);
                ((u32x4*)ob)[64 * j + lane] = x; }
        }
    }
}
__device__ __forceinline__ void ln2_f32(const float* xa, const float* xb, bool hasB, const float* g, const float* bta, bf16_t* oa, bf16_t* ob, int lane) {
    f32x4 va[8], vb[8]; float sa = 0.f, sb = 0.f;
#pragma unroll
    for (int j = 0; j < 8; ++j) { va[j] = __builtin_nontemporal_load((const f32x4*)xa + 64 * j + lane); vb[j] = __builtin_nontemporal_load((const f32x4*)xb + 64 * j + lane); }
#pragma unroll
    for (int j = 0; j < 8; ++j) { sa += (va[j][0] + va[j][1]) + (va[j][2] + va[j][3]); sb += (vb[j][0] + vb[j][1]) + (vb[j][2] + vb[j][3]); }
    const float ma = wave_sum(sa) * (1.f / D), mb = wave_sum(sb) * (1.f / D); float qa = 0.f, qb = 0.f;
#pragma unroll
    for (int j = 0; j < 8; ++j) { va[j] = va[j] - ma; vb[j] = vb[j] - mb;
        qa += (va[j][0] * va[j][0] + va[j][1] * va[j][1]) + (va[j][2] * va[j][2] + va[j][3] * va[j][3]);
        qb += (vb[j][0] * vb[j][0] + vb[j][1] * vb[j][1]) + (vb[j][2] * vb[j][2] + vb[j][3] * vb[j][3]); }
    const float ra = 1.f / sqrtf(wave_sum(qa) * (1.f / D) + LN_EPS), rb = 1.f / sqrtf(wave_sum(qb) * (1.f / D) + LN_EPS);
#pragma unroll
    for (int j = 0; j < 8; ++j) {
        const f32x4 gg = ((const f32x4*)g)[64 * j + lane], bb = ((const f32x4*)bta)[64 * j + lane];
        const f32x4 ya = va[j] * ra * gg + bb, yb = vb[j] * rb * gg + bb;
        u32x2 w; w.x = cvt_pk_bf16(ya[0], ya[1]); w.y = cvt_pk_bf16(ya[2], ya[3]); ((u32x2*)oa)[64 * j + lane] = w;
        if (hasB) { u32x2 x; x.x = cvt_pk_bf16(yb[0], yb[1]); x.y = cvt_pk_bf16(yb[2], yb[3]); ((u32x2*)ob)[64 * j + lane] = x; }
    }
}
__device__ __forceinline__ void sincos_d(float ang, float& c, float& s) {
    const double a = (double)ang; const double k = rint(a * 0.63661977236758134308);
    double r = fma(-k, 1.5707963267948966192, a); r = fma(-k, 6.123233995736766e-17, r);
    const int q = ((int)k) & 3; const double r2 = r * r;
    const double sp = r * (1.0 + r2 * (-1.0 / 6.0 + r2 * (1.0 / 120.0 + r2 * (-1.0 / 5040.0 + r2 * (1.0 / 362880.0 + r2 * (-1.0 / 39916800.0 + r2 * (1.0 / 6227020800.0)))))));
    const double cp = 1.0 + r2 * (-0.5 + r2 * (1.0 / 24.0 + r2 * (-1.0 / 720.0 + r2 * (1.0 / 40320.0 + r2 * (-1.0 / 3628800.0 + r2 * (1.0 / 479001600.0 + r2 * (-1.0 / 87178291200.0)))))));
    const double ss = (q == 0) ? sp : (q == 1) ? cp : (q == 2) ? -sp : -cp;
    const double cc = (q == 0) ? cp : (q == 1) ? -sp : (q == 2) ? -cp : sp;
    c = (float)cc; s = (float)ss;
}
__device__ __forceinline__ double dpowi(double base, int n) { double r = 1.0, b = base; for (int i = 0; i < 8; ++i) { if (n & 1) r *= b; b *= b; n >>= 1; } return r; }

__device__ __forceinline__ void late_transposes(KArgs a, unsigned char* lds, int tid, int gw, int NGW) {
    const int wave = tid >> 6, lane = tid & 63;
    transposes<1>(a, (float*)(lds + wave * 16896), lane, gw, NGW);
}

__device__ __forceinline__ void phase0(KArgs a, unsigned char* lds, int tid, int G) {
    const int wave = tid >> 6, lane = tid & 63;
    const int gw = blockIdx.x * 8 + wave, NGW = G * 8;
    unsigned char* ws = a->ws;
    float* scr = (float*)(lds + wave * 16896);
    transposes<0>(a, scr, lane, gw, NGW);
    bf16_t* H = (bf16_t*)(ws + WS_H); bf16_t* MIX = (bf16_t*)(ws + WS_MIX);
    for (int row = M + gw; row < MPAD; row += NGW) {
        const u32x4 z = (u32x4){0u, 0u, 0u, 0u};
#pragma unroll
        for (int j = 0; j < 4; ++j) { ((u32x4*)(H + (size_t)row * D))[64 * j + lane] = z; ((u32x4*)(MIX + (size_t)row * D))[64 * j + lane] = z; }
    }
    for (int row = gw; row < M; row += 2 * NGW) {
        const int rowb = row + NGW; const bool hasB = rowb < M; const int rb = hasB ? rowb : row;
        const float* sa = row < SROW ? a->in[0] + (size_t)row * D : row < MR ? a->in[1] + (size_t)(row - SROW) * D : a->in[5] + (size_t)((row - METAROW) & 15) * D;
        const float* sb = rb < SROW ? a->in[0] + (size_t)rb * D : rb < MR ? a->in[1] + (size_t)(rb - SROW) * D : a->in[5] + (size_t)((rb - METAROW) & 15) * D;
        ln2_f32(sa, sb, hasB, a->in[6], a->in[7], H + (size_t)row * D, H + (size_t)rb * D, lane);
    }
    float* cosR = (float*)(ws + WS_TAB); float* sinR = cosR + NPOS * 128; float* cosS = sinR + NPOS * 128; float* sinS = cosS + NPOS * 8;
    const int gt = blockIdx.x * 512 + tid, NGT = G * 512;
    for (int i = gt; i < NPOS * 128; i += NGT) {
        const int pi = i >> 7, f = i & 127; const int pos = pi < LP ? pi : 16384 + (pi - LP);
        const float inv = (float)dpowi(0.9300449458481392, f);
        float c, s; sincos_d((float)pos * inv, c, s); cosR[i] = c; sinR[i] = s;
    }
    for (int i = gt; i < NPOS * 8; i += NGT) {
        const int pi = i >> 3, f = i & 7; const int pos = pi < LP ? pi : 16384 + (pi - LP);
        const float inv = (float)dpowi(0.19392274474868576, f);
        float c, s; sincos_d((float)pos * inv, c, s); cosS[i] = c; sinS[i] = s;
    }
    for (int i0 = gt; i0 < 128 * 120 * 32; i0 += 4 * NGT) {
        f32x4 kv[4], vv[4];
#pragma unroll
        for (int u = 0; u < 4; ++u) { const int i = i0 + u * NGT; if (i < 128 * 120 * 32) { const int b = i / (120 * 32), rem = i - b * (120 * 32); const size_t so = (size_t)b * 128 * 128 + 8 * 128 + (size_t)rem * 4;
            kv[u] = __builtin_nontemporal_load((const f32x4*)(a->in[3] + so)); vv[u] = __builtin_nontemporal_load((const f32x4*)(a->in[4] + so)); } }
#pragma unroll
        for (int u = 0; u < 4; ++u) { const int i = i0 + u * NGT; if (i < 128 * 120 * 32) { const int b = i / (120 * 32), rem = i - b * (120 * 32); const size_t dst = (size_t)b * 128 * 128 + (size_t)rem * 4;
            *(f32x4*)(a->out + OFF_KS + dst) = kv[u]; *(f32x4*)(a->out + OFF_VS + dst) = vv[u]; } }
    }
}

__device__ __forceinline__ void retA_item(unsigned char* lds, const bf16_t* Z, bf16_t* U, int item, int tid) {
    asm volatile("" : "+v"(tid));
    const int bh = item < 256 ? (item >> 4) : (item - 256), c = item < 256 ? 1 + (item & 15) : 0, b = bh >> 2, h = bh & 3;
    const int C = c == 0 ? 16 : 128, tok0 = c == 0 ? 0 : 16 + 128 * (c - 1);
    const size_t row0 = c == 0 ? (size_t)METAROW + b * 16 : (size_t)b * 2048 + 128 * (c - 1);
    const int wave = __builtin_amdgcn_readfirstlane(tid >> 6), lane = tid & 63, fr = lane & 15, fq = lane >> 4;
    bf16_t* Vt = (bf16_t*)lds; bf16_t* Kt = (bf16_t*)(lds + 69632);
    const float lg = lg2gamma(h);
    const int dim0 = 8 * (4 * wave + fq);
    {
        u32x4 ka[4], kb[4], va[4], vb[4];
#pragma unroll
        for (int i = 0; i < 4; ++i) {
            const int j0 = 2 * (16 * i + fr);
            ka[i] = (u32x4){0u, 0u, 0u, 0u}; kb[i] = ka[i]; va[i] = ka[i]; vb[i] = ka[i];
            if (j0 < C) { const bf16_t* p = Z + (row0 + j0) * PW + h * 256 + dim0; ka[i] = *(const u32x4*)(p + ZK); va[i] = *(const u32x4*)(p + ZV); }
            if (j0 + 1 < C) { const bf16_t* p = Z + (row0 + j0 + 1) * PW + h * 256 + dim0; kb[i] = *(const u32x4*)(p + ZK); vb[i] = *(const u32x4*)(p + ZV); }
        }
#pragma unroll
        for (int i = 0; i < 4; ++i) {
            const int j0 = 2 * (16 * i + fr);
            const float w0 = fexp2((float)(C - 1 - j0) * lg), w1 = fexp2((float)(C - 2 - j0) * lg);
#pragma unroll
            for (int u = 0; u < 8; ++u) {
                const unsigned wa = ka[i][u >> 1], wb = kb[i][u >> 1], xa = va[i][u >> 1], xb = vb[i][u >> 1];
                const unsigned k_a = (u & 1) ? (wa >> 16) : (wa & 0xffffu), k_b = (u & 1) ? (wb >> 16) : (wb & 0xffffu);
                const unsigned v_a = (u & 1) ? (xa >> 16) : (xa & 0xffffu), v_b = (u & 1) ? (xb >> 16) : (xb & 0xffffu);
                *(unsigned*)(Kt + (dim0 + u) * 136 + j0) = cvt_pk_bf16(bf2f(k_a) * w0, bf2f(k_b) * w1);
                *(unsigned*)(Vt + (dim0 + u) * 136 + j0) = v_a | (v_b << 16);
            }
        }
    }
    __syncthreads();
    const int nks = C == 16 ? 1 : 4;
    bf16_t* Uo = U + (size_t)(bh * 17 + c) * 65536;
#pragma unroll 1
    for (int pass = 0; pass < 2; ++pass) {
        f32x4 acc[2][8];
#pragma unroll
        for (int et = 0; et < 2; ++et)
#pragma unroll
            for (int dt = 0; dt < 8; ++dt) acc[et][dt] = (f32x4){0.f, 0.f, 0.f, 0.f};
#pragma unroll
        for (int ks = 0; ks < 4; ++ks) if (ks < nks) {
            const bf16x8 a0 = *(const bf16x8*)(Vt + (32 * wave + fr) * 136 + 32 * ks + 8 * fq);
            const bf16x8 a1 = *(const bf16x8*)(Vt + (32 * wave + 16 + fr) * 136 + 32 * ks + 8 * fq);
#pragma unroll
            for (int dt = 0; dt < 8; ++dt) {
                const bf16x8 bb = *(const bf16x8*)(Kt + (128 * pass + 16 * dt + fr) * 136 + 32 * ks + 8 * fq);
                acc[0][dt] = mfma16(bb, a0, acc[0][dt]); acc[1][dt] = mfma16(bb, a1, acc[1][dt]);
            }
        }
#pragma unroll
        for (int et = 0; et < 2; ++et)
#pragma unroll
            for (int dt = 0; dt < 8; ++dt)
            { u32x2 w; w.x = cvt_pk_bf16(acc[et][dt][0], acc[et][dt][1]); w.y = cvt_pk_bf16(acc[et][dt][2], acc[et][dt][3]);
              *(u32x2*)(Uo + (32 * wave + 16 * et + fr) * 256 + 128 * pass + 16 * dt + 4 * fq) = w; }
    }
    __syncthreads();
}

__device__ __forceinline__ void ret_scan(const bf16_t* U, bf16_t* Sb, float* out, int tid, int G) {
    for (int idx = blockIdx.x * 512 + tid; idx < 16 * 8192; idx += G * 512) {
        const int bh = idx >> 13, rem = idx & 8191, e = rem >> 5, d8 = (rem & 31) * 8, h = bh & 3;
        const float g128 = fexp2(128.f * lg2gamma(h));
        const bf16_t* Up = U + (size_t)bh * 17 * 65536 + e * 256 + d8;
        bf16_t* Sp = Sb + (size_t)bh * 16 * 65536 + e * 256 + d8;
        u32x4 ur[17];
#pragma unroll
        for (int c = 0; c < 17; ++c) ur[c] = *(const u32x4*)(Up + (size_t)c * 65536);
        f32x4 S0, S1; unpack8(ur[0], S0, S1);
#pragma unroll
        for (int c = 0; c < 17; ++c) {
            if (c > 0) { f32x4 u0, u1; unpack8(ur[c], u0, u1); S0 = S0 * g128 + u0; S1 = S1 * g128 + u1; }
            if (c < 16) { u32x4 w; w.x = cvt_pk_bf16(S0[0], S0[1]); w.y = cvt_pk_bf16(S0[2], S0[3]); w.z = cvt_pk_bf16(S1[0], S1[1]); w.w = cvt_pk_bf16(S1[2], S1[3]); *(u32x4*)(Sp + (size_t)c * 65536) = w; }
        }
        float* o = out + OFF_RSP + (size_t)bh * 65536 + (size_t)d8 * 256 + e;
        o[0] = S0[0]; o[256] = S0[1]; o[512] = S0[2]; o[768] = S0[3]; o[1024] = S1[0]; o[1280] = S1[1]; o[1536] = S1[2]; o[1792] = S1[3];
    }
}

__device__ __forceinline__ void retC_item(unsigned char* lds, const bf16_t* Z, const bf16_t* Sb, bf16_t* MIX, int item, int tid) {
    asm volatile("" : "+v"(tid));
    const int bh = item < 256 ? (item >> 4) : (item - 256), c = item < 256 ? 1 + (item & 15) : 0, b = bh >> 2, h = bh & 3;
    const int C = c == 0 ? 16 : 128, tok0 = c == 0 ? 0 : 16 + 128 * (c - 1);
    const size_t row0 = c == 0 ? (size_t)METAROW + b * 16 : (size_t)b * 2048 + 128 * (c - 1);
    const int wave = __builtin_amdgcn_readfirstlane(tid >> 6), lane = tid & 63, fr = lane & 15, fq = lane >> 4;
    bf16_t* Qs = (bf16_t*)lds; bf16_t* Ks = (bf16_t*)(lds + 67584); bf16_t* Vt = Ks;
    const float lg = lg2gamma(h);
    {
        u32x4 vq[8], vk[8];
#pragma unroll
        for (int i = 0; i < 8; ++i) {
            const int q = tid + 512 * i, r = q >> 5, ch = q & 31;
            vq[i] = (u32x4){0u, 0u, 0u, 0u}; vk[i] = vq[i];
            if (r < C) { const bf16_t* p = Z + (row0 + r) * PW + h * 256 + 8 * ch; vq[i] = *(const u32x4*)(p + ZQ); vk[i] = *(const u32x4*)(p + ZK); }
        }
#pragma unroll
        for (int i = 0; i < 8; ++i) { const int q = tid + 512 * i, r = q >> 5, ch = q & 31; *(u32x4*)(Qs + r * 264 + 8 * ch) = vq[i]; *(u32x4*)(Ks + r * 264 + 8 * ch) = vk[i]; }
    }
    const bf16_t* S = Sb + ((size_t)(bh * 16 + (c > 0 ? c - 1 : 0))) * 65536;
    u32x4 vra[4], vrb[4], sr[8];
    {
        const int dim0 = 8 * (4 * wave + fq);
#pragma unroll
        for (int i = 0; i < 4; ++i) {
            const int j0 = 2 * (16 * i + fr);
            vra[i] = (u32x4){0u, 0u, 0u, 0u}; vrb[i] = vra[i];
            if (j0 < C) vra[i] = *(const u32x4*)(Z + (row0 + j0) * PW + ZV + h * 256 + dim0);
            if (j0 + 1 < C) vrb[i] = *(const u32x4*)(Z + (row0 + j0 + 1) * PW + ZV + h * 256 + dim0);
        }
        if (c > 0) {
            int t2 = tid; asm volatile("" : "+v"(t2));
#pragma unroll
            for (int i = 0; i < 8; ++i) { const int q = t2 + 512 * i, r = q >> 5, ch = q & 31; sr[i] = *(const u32x4*)(S + r * 256 + 8 * ch); }
        }
    }
    asm volatile("" ::: "memory");
    __syncthreads();
    const int i0 = 16 * wave; const bool act = i0 < C;
    bf16x8 qf[8];
#pragma unroll
    for (int ks = 0; ks < 8; ++ks) qf[ks] = *(const bf16x8*)(Qs + (i0 + fr) * 264 + 32 * ks + 8 * fq);
    bf16x8 pf[4];
#pragma unroll
    for (int ks2 = 0; ks2 < 4; ++ks2) {
        f32x4 sA = (f32x4){0.f, 0.f, 0.f, 0.f}, sB = sA;
        if (act && 2 * ks2 <= wave) {
#pragma unroll
            for (int ks = 0; ks < 8; ++ks) { const bf16x8 kf = *(const bf16x8*)(Ks + (32 * ks2 + fr) * 264 + 32 * ks + 8 * fq); sA = mfma16(kf, qf[ks], sA); }
        }
        if (act && 2 * ks2 + 1 <= wave) {
#pragma unroll
            for (int ks = 0; ks < 8; ++ks) { const bf16x8 kf = *(const bf16x8*)(Ks + (32 * ks2 + 16 + fr) * 264 + 32 * ks + 8 * fq); sB = mfma16(kf, qf[ks], sB); }
        }
        float pa[4], pb[4];
#pragma unroll
        for (int r = 0; r < 4; ++r) {
            const int dA = (i0 + fr) - (32 * ks2 + 4 * fq + r), dB = dA - 16;
            pa[r] = dA >= 0 ? sA[r] * fexp2((float)dA * lg) : 0.f;
            pb[r] = dB >= 0 ? sB[r] * fexp2((float)dB * lg) : 0.f;
        }
        u32x4 w; w.x = cvt_pk_bf16(pa[0], pa[1]); w.y = cvt_pk_bf16(pa[2], pa[3]); w.z = cvt_pk_bf16(pb[0], pb[1]); w.w = cvt_pk_bf16(pb[2], pb[3]);
        pf[ks2] = as_bf16x8(w);
    }
    __syncthreads();
    {
        const int dim0 = 8 * (4 * wave + fq);
#pragma unroll
        for (int i = 0; i < 4; ++i) {
            const int j0 = 2 * (16 * i + fr);
#pragma unroll
            for (int u = 0; u < 8; ++u) {
                const unsigned xa = vra[i][u >> 1], xb = vrb[i][u >> 1];
                const unsigned v_a = (u & 1) ? (xa >> 16) : (xa & 0xffffu), v_b = (u & 1) ? (xb >> 16) : (xb & 0xffffu);
                *(unsigned*)(Vt + (dim0 + u) * 136 + j0) = v_a | (v_b << 16);
            }
        }
        if (c > 0) {
            int t2 = tid; asm volatile("" : "+v"(t2));
#pragma unroll
            for (int i = 0; i < 8; ++i) { const int q = t2 + 512 * i, r = q >> 5, ch = q & 31; *(u32x4*)(Qs + r * 264 + 8 * ch) = sr[i]; }
#pragma unroll
            for (int i = 0; i < 8; ++i) { const int q = t2 + 512 * i, r = q >> 5, ch = q & 31; sr[i] = *(const u32x4*)(S + (128 + r) * 256 + 8 * ch); }
        }
    }
    asm volatile("" ::: "memory");
    __syncthreads();
    f32x4 acc[16];
#pragma unroll
    for (int et = 0; et < 16; ++et) acc[et] = (f32x4){0.f, 0.f, 0.f, 0.f};
    if (c > 0) {
        if (act) {
#pragma unroll
            for (int et = 0; et < 8; ++et)
            {
#pragma unroll
                for (int ks = 0; ks < 8; ++ks) { const bf16x8 sf = *(const bf16x8*)(Qs + (16 * et + fr) * 264 + 32 * ks + 8 * fq); acc[et] = mfma16(qf[ks], sf, acc[et]); }
                asm volatile("" ::: "memory");
            }
        }
        __syncthreads();
        {
            int t2 = tid; asm volatile("" : "+v"(t2));
#pragma unroll
            for (int i = 0; i < 8; ++i) { const int q = t2 + 512 * i, r = q >> 5, ch = q & 31; *(u32x4*)(Qs + r * 264 + 8 * ch) = sr[i]; }
        }
        __syncthreads();
        if (act) {
#pragma unroll
            for (int et = 8; et < 16; ++et)
            {
#pragma unroll
                for (int ks = 0; ks < 8; ++ks) { const bf16x8 sf = *(const bf16x8*)(Qs + (16 * (et - 8) + fr) * 264 + 32 * ks + 8 * fq); acc[et] = mfma16(qf[ks], sf, acc[et]); }
                asm volatile("" ::: "memory");
            }
#pragma unroll
            for (int r = 0; r < 4; ++r) { const float sc = fexp2((float)(i0 + 4 * fq + r + 1) * lg);
#pragma unroll
                for (int et = 0; et < 16; ++et) acc[et][r] *= sc; }
        }
    }
    if (act) {
#pragma unroll
        for (int et = 0; et < 16; ++et) {
#pragma unroll
            for (int ks2 = 0; ks2 < 4; ++ks2) if (2 * ks2 <= wave) {
                const u32x2 v0 = *(const u32x2*)(Vt + (16 * et + fr) * 136 + 32 * ks2 + 4 * fq), v1 = *(const u32x2*)(Vt + (16 * et + fr) * 136 + 32 * ks2 + 16 + 4 * fq);
                acc[et] = mfma16(pf[ks2], as_bf16x8((u32x4){v0.x, v0.y, v1.x, v1.y}), acc[et]);
            }
            if (et & 1) asm volatile("" ::: "memory");
        }
    }
    __syncthreads();
    if (act) {
        float* T = (float*)lds + wave * (16 * 260);
#pragma unroll
        for (int r = 0; r < 4; ++r) {
            float s = 0.f;
#pragma unroll
            for (int et = 0; et < 16; ++et) s += acc[et][r];
            s += __shfl_xor(s, 1); s += __shfl_xor(s, 2); s += __shfl_xor(s, 4); s += __shfl_xor(s, 8);
            const float mean = s * (1.f / 256.f); float q = 0.f;
#pragma unroll
            for (int et = 0; et < 16; ++et) { const float dl = acc[et][r] - mean; q += dl * dl; }
            q += __shfl_xor(q, 1); q += __shfl_xor(q, 2); q += __shfl_xor(q, 4); q += __shfl_xor(q, 8);
            const float rstd = 1.f / sqrtf(q * (1.f / 256.f) + LN_EPS);
#pragma unroll
            for (int et = 0; et < 16; ++et) T[(4 * fq + r) * 260 + 16 * et + fr] = (acc[et][r] - mean) * rstd;
        }
        asm volatile("s_waitcnt lgkmcnt(0)" ::: "memory");
        int l2 = lane; asm volatile("" : "+v"(l2));
        u32x4 gt8[8];
#pragma unroll
        for (int k = 0; k < 8; ++k) { const int q = l2 + 64 * k, r = q >> 5, ch = q & 31, i = i0 + r; gt8[k] = (u32x4){0u, 0u, 0u, 0u}; if (i < C) gt8[k] = *(const u32x4*)(Z + (row0 + i) * PW + ZG + h * 256 + 8 * ch); }
#pragma unroll
        for (int k = 0; k < 8; ++k) {
            const int q = l2 + 64 * k, r = q >> 5, ch = q & 31, i = i0 + r;
            if (i < C) {
                const f32x4 x0 = *(const f32x4*)(T + r * 260 + 8 * ch), x1 = *(const f32x4*)(T + r * 260 + 8 * ch + 4);
                const u32x4 gg = gt8[k];
                u32x4 w;
                w.x = cvt_pk_bf16(x0[0] * bf2f(gg.x & 0xffffu), x0[1] * bf2f(gg.x >> 16)); w.y = cvt_pk_bf16(x0[2] * bf2f(gg.y & 0xffffu), x0[3] * bf2f(gg.y >> 16));
                w.z = cvt_pk_bf16(x1[0] * bf2f(gg.z & 0xffffu), x1[1] * bf2f(gg.z >> 16)); w.w = cvt_pk_bf16(x1[2] * bf2f(gg.w & 0xffffu), x1[3] * bf2f(gg.w >> 16));
                *(u32x4*)(MIX + (row0 + i) * D + h * 256 + 8 * ch) = w;
            }
        }
    }
    __syncthreads();
}

template <bool SAMPLE>
__device__ __forceinline__ void swa_item(unsigned char* lds, const bf16_t* Z, const float* ck, const float* cv, const float* sinks, bf16_t* MIX, int item, int tid) {
    asm volatile("" : "+v"(tid));
    const int wave = __builtin_amdgcn_readfirstlane(tid >> 6), lane = tid & 63, fr = lane & 15, fq = lane >> 4;
    bf16_t* Kb = (bf16_t*)lds; bf16_t* Vt = (bf16_t*)(lds + 39168);
    int b, blk = 0, g, nkeys, nit, kmin, tbase = 0;
    if (SAMPLE) { b = item >> 1; g = item & 1; nkeys = 136; nit = 1; kmin = 0; }
    else { b = item / 34; const int rem = item - b * 34; blk = rem >> 1; g = rem & 1; nkeys = 256; nit = blk == 16 ? 1 : 8; kmin = blk == 0 ? 128 : 0; tbase = blk * 128 - 128; }
#define SWA_RAW(kk_, ch_, zoff_, cache_, r0_, r1_) do { r0_ = (f32x4){0.f, 0.f, 0.f, 0.f}; r1_ = r0_; \
        if (SAMPLE) { if ((kk_) < 128) { const float* p_ = (cache_) + ((size_t)(b * 128 + (kk_)) * 2 + g) * 64 + 8 * (ch_); r0_ = *(const f32x4*)p_; r1_ = *(const f32x4*)(p_ + 4); } \
                      else if ((kk_) < 136) r0_ = *(const f32x4*)(Z + (size_t)(SROW + b * 8 + (kk_) - 128) * PW + (zoff_) + g * 64 + 8 * (ch_)); } \
        else { const int tp_ = tbase + (kk_); if ((kk_) < 256 && tp_ >= 0 && tp_ < LP) r0_ = *(const f32x4*)(Z + (size_t)prow(b, tp_) * PW + (zoff_) + g * 64 + 8 * (ch_)); } } while (0)
#define SWA_CVT(kk_, r0_, r1_, out_) do { union { f32x4 f; u32x4 u; } x_; x_.f = r0_; out_ = x_.u; \
        if (SAMPLE && (kk_) < 128) { out_.x = cvt_pk_bf16(r0_[0], r0_[1]); out_.y = cvt_pk_bf16(r0_[2], r0_[3]); out_.z = cvt_pk_bf16(r1_[0], r1_[1]); out_.w = cvt_pk_bf16(r1_[2], r1_[3]); } } while (0)
    {
        f32x4 k0[5], k1[5], va0[3], va1[3], vb0[3], vb1[3];
#pragma unroll
        for (int i = 0; i < 5; ++i) { const int q = tid + 512 * i, kk = q >> 3, ch = q & 7; k0[i] = (f32x4){0.f, 0.f, 0.f, 0.f}; k1[i] = k0[i]; if (q < 272 * 8) SWA_RAW(kk, ch, ZSK, ck, k0[i], k1[i]); }
#pragma unroll
        for (int i = 0; i < 3; ++i) { const int q = tid + 512 * i, ch = q / 140, pr = q - ch * 140; va0[i] = (f32x4){0.f, 0.f, 0.f, 0.f}; va1[i] = va0[i]; vb0[i] = va0[i]; vb1[i] = va0[i];
            if (q < 140 * 8) { SWA_RAW(2 * pr, ch, ZSV, cv, va0[i], va1[i]); SWA_RAW(2 * pr + 1, ch, ZSV, cv, vb0[i], vb1[i]); } }
#pragma unroll
        for (int i = 0; i < 5; ++i) { const int q = tid + 512 * i, kk = q >> 3, ch = q & 7; if (q < 272 * 8) { u32x4 v; SWA_CVT(kk, k0[i], k1[i], v); *(u32x4*)(Kb + kk * 72 + 8 * ch) = v; } }
#pragma unroll
        for (int i = 0; i < 3; ++i) {
            const int q = tid + 512 * i, ch = q / 140, pr = q - ch * 140;
            if (q < 140 * 8) {
                u32x4 va, vb; SWA_CVT(2 * pr, va0[i], va1[i], va); SWA_CVT(2 * pr + 1, vb0[i], vb1[i], vb);
#pragma unroll
                for (int u = 0; u < 8; ++u) {
                    const unsigned xa = va[u >> 1], xb = vb[u >> 1];
                    const unsigned v_a = (u & 1) ? (xa >> 16) : (xa & 0xffffu), v_b = (u & 1) ? (xb >> 16) : (xb & 0xffffu);
                    *(unsigned*)(Vt + (8 * ch + u) * 280 + 2 * pr) = v_a | (v_b << 16);
                }
            }
        }
    }
#undef SWA_RAW
#undef SWA_CVT
    __syncthreads();
    const int hq = g * 8 + wave; const float sink = sinks[hq];
#define SWA_LOADQ(it_, d0, d1) do { const int iq_ = 16 * (it_) + fr; bool qv_; size_t rowq_; \
        if (SAMPLE) { qv_ = fr < 8; rowq_ = (size_t)SROW + b * 8 + (fr & 7); } else { const int tq_ = blk * 128 + iq_; qv_ = tq_ < LP; rowq_ = (size_t)prow(b, qv_ ? tq_ : 0); } \
        d0 = (u32x4){0u, 0u, 0u, 0u}; d1 = d0; \
        if (qv_) { const bf16_t* p_ = Z + rowq_ * PW + ZSQ + hq * 64 + 8 * fq; d0 = *(const u32x4*)p_; d1 = *(const u32x4*)(p_ + 32); } } while (0)
    u32x4 q0n, q1n; SWA_LOADQ(0, q0n, q1n);
#pragma unroll 1
    for (int it = 0; it < nit; ++it) {
        const int i0 = 16 * it, iq = i0 + fr;
        const bf16x8 q0 = as_bf16x8(q0n), q1 = as_bf16x8(q1n);
        if (it + 1 < nit) SWA_LOADQ(it + 1, q0n, q1n);
        f32x4 s[10];
#pragma unroll
        for (int jj = 0; jj < 10; ++jj) {
            const bf16_t* kp = Kb + (16 * (it + jj) + fr) * 72 + 8 * fq;
            s[jj] = mfma16(*(const bf16x8*)kp, q0, (f32x4){0.f, 0.f, 0.f, 0.f});
            s[jj] = mfma16(*(const bf16x8*)(kp + 32), q1, s[jj]);
        }
        float mx = sink;
#pragma unroll
        for (int jj = 0; jj < 10; ++jj)
#pragma unroll
            for (int r = 0; r < 4; ++r) {
                const int kk = 16 * (it + jj) + 4 * fq + r;
                const bool ok = (kk > iq) && (kk <= iq + 128) && (kk >= kmin) && (kk < nkeys);
                s[jj][r] = ok ? s[jj][r] : -1e30f; mx = fmaxf(mx, s[jj][r]);
            }
        mx = fmaxf(mx, __shfl_xor(mx, 16)); mx = fmaxf(mx, __shfl_xor(mx, 32));
        float sum = 0.f;
#pragma unroll
        for (int jj = 0; jj < 10; ++jj)
#pragma unroll
            for (int r = 0; r < 4; ++r) { s[jj][r] = fexp(s[jj][r] - mx); sum += s[jj][r]; }
        sum += __shfl_xor(sum, 16); sum += __shfl_xor(sum, 32);
        const float inv = 1.f / (sum + fexp(sink - mx));
        bf16x8 pf[5];
#pragma unroll
        for (int k2 = 0; k2 < 5; ++k2) {
            u32x4 w; w.x = cvt_pk_bf16(s[2 * k2][0] * inv, s[2 * k2][1] * inv); w.y = cvt_pk_bf16(s[2 * k2][2] * inv, s[2 * k2][3] * inv);
            w.z = cvt_pk_bf16(s[2 * k2 + 1][0] * inv, s[2 * k2 + 1][1] * inv); w.w = cvt_pk_bf16(s[2 * k2 + 1][2] * inv, s[2 * k2 + 1][3] * inv);
            pf[k2] = as_bf16x8(w);
        }
        f32x4 o[4];
#pragma unroll
        for (int dt = 0; dt < 4; ++dt) {
            o[dt] = (f32x4){0.f, 0.f, 0.f, 0.f};
#pragma unroll
            for (int k2 = 0; k2 < 5; ++k2) {
                const bf16_t* vp = Vt + (16 * dt + fr) * 280 + 16 * (it + 2 * k2) + 4 * fq;
                const u32x2 v0 = *(const u32x2*)vp, v1 = *(const u32x2*)(vp + 16);
                o[dt] = mfma16(pf[k2], as_bf16x8((u32x4){v0.x, v0.y, v1.x, v1.y}), o[dt]);
            }
        }
#pragma unroll
        for (int r = 0; r < 4; ++r) {
            const int i = i0 + 4 * fq + r; bool ok; size_t row;
            if (SAMPLE) { ok = i < 8; row = (size_t)SROW + b * 8 + i; } else { const int tq = blk * 128 + i; ok = tq < LP; row = (size_t)prow(b, ok ? tq : 0); }
            if (ok) { bf16_t* mp = MIX + row * D + 1024 + hq * 64 + fr;
#pragma unroll
                for (int dt = 0; dt < 4; ++dt) mp[16 * dt] = f2bf(o[dt][r]); }
        }
    }
    __syncthreads();
}

#undef SWA_LOADQ
template <int MODE>
__device__ __forceinline__ void retS_item(unsigned char* lds, const bf16_t* Z, const float* state, float* out, bf16_t* MIX, bf16_t* SKV, int item, int tid) {
    asm volatile("" : "+v"(tid));
    const int b = item >> 2, h = item & 3; const size_t row0 = (size_t)SROW + b * 8;
    const int wave = __builtin_amdgcn_readfirstlane(tid >> 6), lane = tid & 63;
    float* qT = (float*)lds; float* kT = qT + 2048; float* vS = kT + 2048; float* sc = vS + 2048; float* cp = sc + 64;
    const float lg = lg2gamma(h);
    {
        const int t = tid >> 6, d4 = (tid & 63) * 4;
        bf16_t* skv = SKV + (size_t)item * 4096 + t * 256 + d4;
        u32x2 rk, rv;
        if (MODE == 0) {
            const bf16_t* p = Z + (row0 + t) * PW + h * 256 + d4;
            const u32x2 rq = *(const u32x2*)(p + ZQ); rk = *(const u32x2*)(p + ZK); rv = *(const u32x2*)(p + ZV);
            *(u32x2*)skv = rk; *(u32x2*)(skv + 2048) = rv;
            qT[(d4 + 0) * 8 + t] = bf2f(rq.x & 0xffffu); qT[(d4 + 1) * 8 + t] = bf2f(rq.x >> 16); qT[(d4 + 2) * 8 + t] = bf2f(rq.y & 0xffffu); qT[(d4 + 3) * 8 + t] = bf2f(rq.y >> 16);
        } else { rk = *(const u32x2*)skv; rv = *(const u32x2*)(skv + 2048); }
        kT[(d4 + 0) * 8 + t] = bf2f(rk.x & 0xffffu); kT[(d4 + 1) * 8 + t] = bf2f(rk.x >> 16); kT[(d4 + 2) * 8 + t] = bf2f(rk.y & 0xffffu); kT[(d4 + 3) * 8 + t] = bf2f(rk.y >> 16);
        *(f32x4*)(vS + t * 256 + d4) = (f32x4){bf2f(rv.x & 0xffffu), bf2f(rv.x >> 16), bf2f(rv.y & 0xffffu), bf2f(rv.y >> 16)};
    }
    __syncthreads();
    if (MODE == 0) {
        const int i = tid >> 6, j = (tid >> 3) & 7, part = tid & 7; float s = 0.f;
#pragma unroll 8
        for (int dd = 0; dd < 32; ++dd) { const int d = part * 32 + dd; s += qT[d * 8 + i] * kT[d * 8 + j]; }
        s += __shfl_xor(s, 1); s += __shfl_xor(s, 2); s += __shfl_xor(s, 4);
        if (part == 0) sc[i * 8 + j] = j <= i ? s * fexp2((float)(i - j) * lg) : 0.f;
    }
    const float* S = state + (size_t)(b * 4 + h) * 65536; float* SO = out + OFF_RSS + (size_t)(b * 4 + h) * 65536;
    const int e4 = lane * 4;
    u32x2 gg = (u32x2){0u, 0u};
    if (MODE == 0) gg = *(const u32x2*)(Z + (row0 + wave) * PW + ZG + h * 256 + e4);
    f32x4 vv[8], cr[8];
#pragma unroll
    for (int j = 0; j < 8; ++j) { vv[j] = *(const f32x4*)(vS + j * 256 + e4) * fexp2((float)(7 - j) * lg); cr[j] = (f32x4){0.f, 0.f, 0.f, 0.f}; }
    const float g8 = fexp2(8.f * lg);
#define RETS_LOAD(buf, db) _Pragma("unroll") for (int u = 0; u < 8; ++u) buf[u] = __builtin_nontemporal_load((const f32x4*)(S + (size_t)(32 * wave + (db) + u) * 256 + e4))
#define RETS_COMP(buf, db) _Pragma("unroll") for (int u = 0; u < 8; ++u) { \
        const int d = 32 * wave + (db) + u; \
        if (MODE == 0) { \
            const f32x4 qa = *(const f32x4*)(qT + d * 8), qb = *(const f32x4*)(qT + d * 8 + 4); \
            cr[0] += buf[u] * qa[0]; cr[1] += buf[u] * qa[1]; cr[2] += buf[u] * qa[2]; cr[3] += buf[u] * qa[3]; \
            cr[4] += buf[u] * qb[0]; cr[5] += buf[u] * qb[1]; cr[6] += buf[u] * qb[2]; cr[7] += buf[u] * qb[3]; \
        } else { \
            const f32x4 ka = *(const f32x4*)(kT + d * 8), kb = *(const f32x4*)(kT + d * 8 + 4); \
            f32x4 sn = buf[u] * g8; \
            sn += vv[0] * ka[0]; sn += vv[1] * ka[1]; sn += vv[2] * ka[2]; sn += vv[3] * ka[3]; \
            sn += vv[4] * kb[0]; sn += vv[5] * kb[1]; sn += vv[6] * kb[2]; sn += vv[7] * kb[3]; \
            __builtin_nontemporal_store(sn, (f32x4*)(SO + (size_t)d * 256 + e4)); } }
    {
        f32x4 sa[8], sb[8];
        RETS_LOAD(sa, 0); RETS_LOAD(sb, 8);
        RETS_COMP(sa, 0); RETS_LOAD(sa, 16);
        RETS_COMP(sb, 8); RETS_LOAD(sb, 24);
        RETS_COMP(sa, 16); RETS_COMP(sb, 24);
    }
#undef RETS_LOAD
#undef RETS_COMP
    if (MODE == 0) {
#pragma unroll
        for (int i = 0; i < 8; ++i) *(f32x4*)(cp + (wave * 8 + i) * 256 + e4) = cr[i];
        __syncthreads();
        const int i = wave; f32x4 o = (f32x4){0.f, 0.f, 0.f, 0.f};
#pragma unroll
        for (int w8 = 0; w8 < 8; ++w8) o += *(const f32x4*)(cp + (w8 * 8 + i) * 256 + e4);
        o *= fexp2((float)(i + 1) * lg);
#pragma unroll
        for (int j = 0; j < 8; ++j) o += *(const f32x4*)(vS + j * 256 + e4) * sc[i * 8 + j];
        const float mean = wave_sum((o[0] + o[1]) + (o[2] + o[3])) * (1.f / 256.f);
        const f32x4 dl = o - mean;
        const float var = wave_sum((dl[0] * dl[0] + dl[1] * dl[1]) + (dl[2] * dl[2] + dl[3] * dl[3])) * (1.f / 256.f);
        const float rstd = 1.f / sqrtf(var + LN_EPS);
        u32x2 w; w.x = cvt_pk_bf16(dl[0] * rstd * bf2f(gg.x & 0xffffu), dl[1] * rstd * bf2f(gg.x >> 16)); w.y = cvt_pk_bf16(dl[2] * rstd * bf2f(gg.y & 0xffffu), dl[3] * rstd * bf2f(gg.y >> 16));
        *(u32x2*)(MIX + (row0 + i) * D + h * 256 + e4) = w;
    }
    __syncthreads();
}

constexpr int NPHASE = 10;
__global__ void __launch_bounds__(512) fwd(Args a_unused) {
    extern __shared__ __attribute__((aligned(16))) unsigned char lds[];
    int lo, hi; { KArgs a = kargs(); lo = a->ph_lo; hi = a->ph_hi; }
    if (hi - lo > 1) {
        if (threadIdx.x == 0) { ((volatile LAS unsigned*)(lds + LDS_CTL))[0] = 0u; ((volatile LAS unsigned*)(lds + LDS_CTL))[1] = 0u; }
        __syncthreads();
        if (threadIdx.x == 0) { KArgs a = kargs(); (void)xb_add((unsigned*)(a->ws + WS_BAR) + XB_XCNT(xb_xcc_id()), 1u); }
    }
#define IN(k) (lo <= (k) && (k) < hi)
#define SEAM(k) do { if (IN(k) && IN((k) + 1)) { for (int _r = 0; _r < REPSYNC; ++_r) { KArgs _a = kargs(); xcd_barrier((unsigned*)(_a->ws + WS_BAR), (volatile LAS unsigned*)(lds + LDS_CTL)); } } } while (0)
#define WSP(T, off) ((T)(a->ws + (off)))
    if (IN(0)) { for (int _r = 0; _r < REP0; ++_r) { KArgs a = kargs(); phase0(a, lds, ltid(), gridDim.x); __syncthreads(); } }
    SEAM(0);
    if (IN(1)) {
        KArgs a = kargs(); const int G = gridDim.x;
        pg8::Gemm g{WSP(const bf16_t*, WS_H), WSP(const bf16_t*, WS_WIN), D, D, PW / 256, 0}; pg8::StaticOrder S; S.init(MR, PW, G, (int)blockIdx.x, 9);
        const float* cosR = WSP(const float*, WS_TAB);
        EpiIn E{WSP(bf16_t*, WS_Z), cosR, cosR + NPOS * 128, cosR + 2 * NPOS * 128, cosR + 2 * NPOS * 128 + NPOS * 8, a->out};
        for (int _r = 0; _r < 1 + ((REPG >> 0) & 1); ++_r) pg8::gemm_phase<EpiIn>((LAS unsigned char*)lds, g, S, E);
    }
    SEAM(1);
    for (int _rm = 0; _rm < REPMIX; ++_rm) {
    if (_rm > 0) { KArgs _a = kargs(); xcd_barrier((unsigned*)(_a->ws + WS_BAR), (volatile LAS unsigned*)(lds + LDS_CTL)); }
    if (IN(2)) {
        KArgs a = kargs(); const int G = gridDim.x, tid = ltid();
        bf16_t* Z = WSP(bf16_t*, WS_Z); bf16_t* MIX = WSP(bf16_t*, WS_MIX);
        unsigned* head = (unsigned*)(a->ws + WS_BAR) + 16;
        volatile LAS unsigned* qw = (volatile LAS unsigned*)(lds + LDS_CTL) + 2;
        for (;;) {
            if (tid == 0) *qw = __hip_atomic_fetch_add(head, 1u, __ATOMIC_RELAXED, __HIP_MEMORY_SCOPE_AGENT);
            __syncthreads();
            const int q = (int)*qw;
            if (q >= 136 + 512 + 272 + 256) break;
            if (q < 136) swa_item<false>(lds, Z, nullptr, nullptr, a->in[10], MIX, q, tid);
            else if (q < 648) retS_item<0>(lds, Z, a->in[2], a->out, MIX, WSP(bf16_t*, WS_SKV), q - 136, tid);
            else if (q < 920) retA_item(lds, Z, WSP(bf16_t*, WS_U), q - 648, tid);
            else swa_item<true>(lds, Z, a->in[3], a->in[4], a->in[10], MIX, q - 920, tid);
        }
    }
    SEAM(2);
    if (IN(3)) { KArgs a = kargs(); ret_scan(WSP(const bf16_t*, WS_U), WSP(bf16_t*, WS_SB), a->out, ltid(), gridDim.x); }
    SEAM(3);
    if (IN(4)) { KArgs a = kargs(); const int G = gridDim.x, tid = ltid(); for (int it = blockIdx.x; it < 256; it += G) retC_item(lds, WSP(const bf16_t*, WS_Z), WSP(const bf16_t*, WS_SB), WSP(bf16_t*, WS_MIX), it, tid); }
    }
    SEAM(4);
    if (IN(5)) {
        KArgs a = kargs(); const int G = gridDim.x;
        pg8::Gemm g{WSP(const bf16_t*, WS_MIX), WSP(const bf16_t*, WS_WO), D, D / 2, D / 256, (size_t)(D / 2) * 2}; pg8::StaticOrder S; S.init(MR, 2 * D, G, (int)blockIdx.x);
        EpiRes E{WSP(bf16_t*, WS_PRE), WSP(const bf16_t*, WS_H), WSP(bf16_t*, WS_Z)};
        for (int _r = 0; _r < 1 + ((REPG >> 1) & 1); ++_r) pg8::gemm_phase<EpiRes>((LAS unsigned char*)lds, g, S, E);
        const int nun = (MR / 256) * (2 * D / 256), rounds = (nun + G - 1) / G, first_idle = nun - (rounds - 1) * G;
        if (first_idle < G) { if ((int)blockIdx.x >= first_idle) { const int tid = ltid(); late_transposes(a, lds, tid, ((int)blockIdx.x - first_idle) * 8 + (tid >> 6), (G - first_idle) * 8); } }
        else { const int tid = ltid(); late_transposes(a, lds, tid, (int)blockIdx.x * 8 + (tid >> 6), G * 8); }
    }
    SEAM(5);
    if (IN(6)) {
        KArgs a = kargs(); const int G = gridDim.x, tid = ltid(), lane = tid & 63, wave = tid >> 6;
        for (int _r = 0; _r < REPLN; ++_r) for (int row = blockIdx.x * 8 + wave; row < MR; row += 2 * G * 8) {
            const int rowb = row + G * 8; const bool hasB = rowb < MR; const int rb = hasB ? rowb : row;
            ln2_bf16<false>(WSP(const bf16_t*, WS_PRE) + (size_t)row * D, WSP(const bf16_t*, WS_Z) + (size_t)row * D, WSP(const bf16_t*, WS_PRE) + (size_t)rb * D, WSP(const bf16_t*, WS_Z) + (size_t)rb * D, hasB,
                            a->in[11], a->in[12], WSP(bf16_t*, WS_H) + (size_t)row * D, WSP(bf16_t*, WS_H) + (size_t)rb * D, lane);
        }
    }
    SEAM(6);
    if (IN(7)) {
        KArgs a = kargs(); const int G = gridDim.x, c = (int)blockIdx.x;
        const pg8::Gemm gu{WSP(const bf16_t*, WS_H), WSP(const bf16_t*, WS_WGU), D, D, 2 * FF / 256, 0};
        const pg8::Gemm gd{WSP(const bf16_t*, WS_A2), WSP(const bf16_t*, WS_WD), FF, FF / 2, D / 256, (size_t)(FF / 2) * 2};
        const EpiGlu Eu{WSP(bf16_t*, WS_A2)};
        const EpiRes Ed{WSP(bf16_t*, WS_PRE), WSP(const bf16_t*, WS_H), WSP(bf16_t*, WS_PRE2)};
        constexpr int NP = MR / 256;
        pg8::StaticOrder S; S.init(MR - 512, 2 * FF, G, c); S.tailM = 2;
        const int nup = S.total(), nfull = nup / G, ntail = nup - nfull * G;
        int np1 = (G - ntail) / 16; if (np1 > NP - 2) np1 = NP - 2;
        const bool cut = ntail > 0 && ntail % 8 == 0 && (G - ntail) == np1 * 16 && G % 8 == 0 && (nfull * G - S.nwg) >= 0 && (hi - lo > 1);
        S.ilim = cut ? nfull : (1 << 20);
        pg8::gemm_phase<EpiGlu>((LAS unsigned char*)lds, gu, S, Eu);
        if (hi - lo > 1) { KArgs _a = kargs(); xcd_barrier((unsigned*)(_a->ws + WS_BAR), (volatile LAS unsigned*)(lds + LDS_CTL)); }
        if (cut) {
            if (c < ntail) {
                S.i0 = nfull; S.ilim = 1 << 20; pg8::gemm_phase<EpiGlu>((LAS unsigned char*)lds, gu, S, Eu);
                const int tid = ltid();
                unsigned* head = (unsigned*)(a->ws + WS_BAR) + 32;
                volatile LAS unsigned* qw = (volatile LAS unsigned*)(lds + LDS_CTL) + 2;
                if (tid == 0) *qw = __hip_atomic_fetch_add(head, 1u, __ATOMIC_RELAXED, __HIP_MEMORY_SCOPE_AGENT);
                __syncthreads();
                const int q = (int)*qw;
                if (q < 512) retS_item<1>(lds, nullptr, a->in[2], a->out, nullptr, WSP(bf16_t*, WS_SKV), q, tid);
            }
            else { pg8::StaticOrder T; T.init(np1 * 256, 2 * D, G - ntail, c - ntail); pg8::gemm_phase<EpiRes>((LAS unsigned char*)lds, gd, T, Ed); }
            { KArgs _a = kargs(); xcd_barrier((unsigned*)(_a->ws + WS_BAR), (volatile LAS unsigned*)(lds + LDS_CTL)); }
        }
        {
            const int p0 = cut ? np1 : 0;
            pg8::StaticOrder T; T.init((NP - p0) * 256, 2 * D, G, c); T.pm0 = p0;
            pg8::gemm_phase<EpiRes>((LAS unsigned char*)lds, gd, T, Ed);
        }
        {
            const int tid = ltid();
            unsigned* head = (unsigned*)(a->ws + WS_BAR) + 32;
            volatile LAS unsigned* qw = (volatile LAS unsigned*)(lds + LDS_CTL) + 2;
            for (;;) {
                if (tid == 0) *qw = __hip_atomic_fetch_add(head, 1u, __ATOMIC_RELAXED, __HIP_MEMORY_SCOPE_AGENT);
                __syncthreads();
                const int q = (int)*qw;
                if (q >= 512) break;
                retS_item<1>(lds, nullptr, a->in[2], a->out, nullptr, WSP(bf16_t*, WS_SKV), q, tid);
            }
        }
    }
    SEAM(8);
    if (IN(9)) {
        KArgs a = kargs(); const int G = gridDim.x, tid = ltid(), lane = tid & 63, wave = tid >> 6;
        for (int _r = 0; _r < REPLN; ++_r) for (int row = blockIdx.x * 8 + wave; row < MR; row += 2 * G * 8) {
            const int rowb = row + G * 8; const bool hasB = rowb < MR; const int rb = hasB ? rowb : row;
            float* da = row < SROW ? a->out + OFF_YP + (size_t)row * D : a->out + OFF_YS + (size_t)(row - SROW) * D;
            float* db = rb < SROW ? a->out + OFF_YP + (size_t)rb * D : a->out + OFF_YS + (size_t)(rb - SROW) * D;
            ln2_bf16<true>(WSP(const bf16_t*, WS_PRE) + (size_t)row * D, WSP(const bf16_t*, WS_PRE2) + (size_t)row * D, WSP(const bf16_t*, WS_PRE) + (size_t)rb * D, WSP(const bf16_t*, WS_PRE2) + (size_t)rb * D, hasB,
                           a->in[16], a->in[17], da, db, lane);
        }
    }
#undef IN
#undef SEAM
#undef WSP
}

extern "C" void kernel_launch(void* const* d_in, const int* in_sizes, int n_in, void* d_out, int out_size, void* d_ws, size_t ws_size, hipStream_t stream) {
    static int grid = 0;
    if (grid == 0) {
        if (n_in != 18 || ws_size < WS_END) { fprintf(stderr, "kernel_launch: unexpected n_in %d / ws_size %zu (need %zu)\n", n_in, ws_size, (size_t)WS_END); grid = -1; return; }
        int dev = 0, cus = 0, per_cu = 0;
        (void)hipGetDevice(&dev);
        (void)hipDeviceGetAttribute(&cus, hipDeviceAttributeMultiprocessorCount, dev);
        (void)hipFuncSetAttribute((const void*)fwd, hipFuncAttributeMaxDynamicSharedMemorySize, LDS_BYTES);
        (void)hipOccupancyMaxActiveBlocksPerMultiprocessor(&per_cu, (const void*)fwd, 512, LDS_BYTES);
        if (per_cu < 1) { fprintf(stderr, "kernel_launch: occupancy query reports %d blocks per CU\n", per_cu); per_cu = 1; }
        grid = cus * 1;
        (void)hipGetLastError();
    }
    if (grid < 0) return;
    Args a{};
    for (int i = 0; i < 18; ++i) a.in[i] = (const float*)d_in[i];
    a.out = (float*)d_out; a.ws = (unsigned char*)d_ws;
#if N_LAUNCH_MODE == 0
    (void)hipMemsetAsync((char*)d_ws + WS_BAR, 0, 3456 * 4, stream);
    a.ph_lo = 0; a.ph_hi = NPHASE;
    void* args[] = {&a};
    hipError_t e = hipLaunchCooperativeKernel((const void*)fwd, dim3(grid), dim3(512), args, LDS_BYTES, stream);
    if (e != hipSuccess) fprintf(stderr, "cooperative launch failed: %s (grid %d)\n", hipGetErrorString(e), grid);
#else
    for (int p = 0; p < NPHASE; ++p) {
        a.ph_lo = p; a.ph_hi = p + 1;
        void* args[] = {&a};
        hipError_t e = hipLaunchCooperativeKernel((const void*)fwd, dim3(grid), dim3(512), args, LDS_BYTES, stream);
        if (e != hipSuccess) fprintf(stderr, "launch %d failed: %s (grid %d)\n", p, hipGetErrorString(e), grid);
    }
#endif
}
```

```cpp
#include <hip/hip_runtime.h>
#include <hip/hip_cooperative_groups.h>
#include <cstdio>
namespace cg = cooperative_groups;

#ifndef N_LAUNCH_MODE
#define N_LAUNCH_MODE 0
#endif

#ifndef REP0
#define REP0 1
#endif
#ifndef REPMIX
#define REPMIX 1
#endif
#ifndef REPLN
#define REPLN 1
#endif
#ifndef REPG
#define REPG 0
#endif
#ifndef REPSYNC
#define REPSYNC 1
#endif
#define LAS __attribute__((address_space(3)))
typedef unsigned short bf16_t;
typedef short bf16x8 __attribute__((ext_vector_type(8)));
typedef float f32x4 __attribute__((ext_vector_type(4)));
typedef unsigned u32x4 __attribute__((ext_vector_type(4)));
typedef unsigned u32x2 __attribute__((ext_vector_type(2)));

constexpr int D = 2048, LP = 2064, MS = 1024, M = 9280, MPAD = 9472, PW = 5376, FF = 5632;
constexpr int SROW = 8192, MR = 9216, METAROW = 9216;
constexpr int ZQ = 0, ZK = 1024, ZV = 2048, ZG = 3072, ZSQ = 4096, ZSK = 5120, ZSV = 5248;
constexpr int NPOS = 2072;
constexpr float ALPHA = 1.189207115002721f, LN_EPS = 1e-5f;
constexpr size_t OFF_YP = 0, OFF_YS = 16777216, OFF_RSP = 18874368, OFF_KP = 19922944, OFF_VP = 19988480,
                 OFF_RSS = 20054016, OFF_KS = 53608448, OFF_VS = 55705600;
constexpr size_t WS_WIN = 0;
constexpr size_t WS_WO = WS_WIN + (size_t)PW * D * 2;
constexpr size_t WS_WGU = WS_WO + (size_t)D * D * 2;
constexpr size_t WS_MIX = WS_WGU + (size_t)2 * FF * D * 2;
constexpr size_t WS_WD = WS_MIX + (size_t)MPAD * D * 2;
constexpr size_t WS_H = WS_WD + (size_t)D * FF * 2;
constexpr size_t WS_PRE = WS_H + (size_t)MPAD * D * 2;
constexpr size_t WS_Z = WS_PRE + (size_t)MPAD * D * 4;
constexpr size_t WS_U = WS_Z + (size_t)MPAD * PW * 2;
constexpr size_t WS_SB = WS_U + (size_t)272 * 65536 * 4;
constexpr size_t WS_TAB = WS_SB + (size_t)256 * 65536 * 2;
constexpr size_t WS_BAR = WS_TAB + (((size_t)NPOS * 128 * 4 * 2 + (size_t)NPOS * 8 * 4 * 2 + 255) / 256) * 256;
constexpr size_t WS_SKV = WS_BAR + 16384;
constexpr size_t WS_END = WS_SKV + (size_t)512 * 2 * 8 * 256 * 2;
constexpr size_t WS_A2 = WS_Z;
constexpr size_t WS_PRE2 = WS_MIX;
static_assert((size_t)MPAD * D * 2 <= WS_WD - WS_MIX, "PRE2 alias");
static_assert((size_t)MPAD * FF * 2 <= WS_SB - WS_Z, "A2 alias");
constexpr int LDS_BYTES = 147456, LDS_CTL = 147440;

__device__ __forceinline__ float lg2gamma(int h) {
    return h == 0 ? -0.04580368961312479f : h == 1 ? -0.02272007650008353f : h == 2 ? -0.011315313227834146f : -0.005646563141142063f;
}
__device__ __forceinline__ int prow(int b, int t) { return t < 16 ? METAROW + b * 16 + t : b * 2048 + (t - 16); }
__device__ __forceinline__ float fexp2(float x) { return __builtin_amdgcn_exp2f(x); }
__device__ __forceinline__ float fexp(float x) { return __builtin_amdgcn_exp2f(x * 1.4426950408889634f); }
__device__ __forceinline__ float bf2f(unsigned b) { return __uint_as_float(b << 16); }
__device__ __forceinline__ unsigned cvt_pk_bf16(float lo, float hi) { unsigned r; asm volatile("v_cvt_pk_bf16_f32 %0, %1, %2" : "=v"(r) : "v"(lo), "v"(hi)); return r; }
__device__ __forceinline__ bf16_t f2bf(float f) { return (bf16_t)(cvt_pk_bf16(f, 0.f) & 0xffffu); }
__device__ __forceinline__ float silu(float x) { return x * __builtin_amdgcn_rcpf(1.f + fexp(-x)); }
__device__ __forceinline__ f32x4 ld4(const float* p, int i) { return ((const f32x4*)p)[i]; }
__device__ __forceinline__ f32x4 ld4(const bf16_t* p, int i) { const u32x2 r = ((const u32x2*)p)[i]; return (f32x4){bf2f(r.x & 0xffffu), bf2f(r.x >> 16), bf2f(r.y & 0xffffu), bf2f(r.y >> 16)}; }
__device__ __forceinline__ void unpack8(const u32x4 r, f32x4& lo, f32x4& hi) {
    lo = (f32x4){bf2f(r.x & 0xffffu), bf2f(r.x >> 16), bf2f(r.y & 0xffffu), bf2f(r.y >> 16)};
    hi = (f32x4){bf2f(r.z & 0xffffu), bf2f(r.z >> 16), bf2f(r.w & 0xffffu), bf2f(r.w >> 16)};
}
__device__ __forceinline__ float wave_sum(float v) {
#pragma unroll
    for (int o = 1; o < 64; o <<= 1) v += __shfl_xor(v, o);
    return v;
}
__device__ __forceinline__ f32x4 mfma16(bf16x8 a, bf16x8 b, f32x4 c) { return __builtin_amdgcn_mfma_f32_16x16x32_bf16(a, b, c, 0, 0, 0); }
__device__ __forceinline__ bf16x8 as_bf16x8(u32x4 v) { union { u32x4 u; bf16x8 b; } x; x.u = v; return x.b; }

struct Args { const float* in[18]; float* out; unsigned char* ws; int ph_lo, ph_hi; };
typedef const __attribute__((address_space(4))) Args* KArgs;
__device__ __forceinline__ KArgs kargs() { KArgs p = (KArgs)__builtin_amdgcn_kernarg_segment_ptr(); asm volatile("" : "+s"(p)); return p; }
__device__ __forceinline__ int ltid() { int t = threadIdx.x; asm volatile("" : "+v"(t)); return t; }


#define XB_TMO      128
#define XB_XCNT(j)  (256  + 64 * (j))
#define XB_XSUB(j)  (1280 + 64 * (j))
#define XB_XGEN(j)  (2304 + 64 * (j))
#define XB_TOP      3328
#define XB_TOPGEN   3392
#define XCD_BAR_WORDS 3456
#define XB_SPIN_CAP (1u << 18)
__device__ __forceinline__ unsigned xb_ld(unsigned* p)              { return __hip_atomic_load(p, __ATOMIC_RELAXED, __HIP_MEMORY_SCOPE_AGENT); }
__device__ __forceinline__ unsigned xb_add(unsigned* p, unsigned v) { return __hip_atomic_fetch_add(p, v, __ATOMIC_RELAXED, __HIP_MEMORY_SCOPE_AGENT); }
__device__ __forceinline__ unsigned xb_xcc_id() { return (unsigned)__builtin_amdgcn_s_getreg((3 << 11) | 20) & 0xFu; }
#define XB_SPIN(cond, bar) do { unsigned _sp = 0; while (cond) { __builtin_amdgcn_s_sleep(1); \
    if ((++_sp & 255u) == 0u) { if (xb_ld(&(bar)[XB_TMO])) break; if (_sp > XB_SPIN_CAP) { atomicAdd(&(bar)[XB_TMO], 1u); break; } } } } while (0)
__device__ __forceinline__ void xcd_barrier_complete(unsigned* bar, unsigned x, unsigned& nloc, unsigned& nx) {
    const unsigned G = gridDim.x * gridDim.y * gridDim.z;
    unsigned sum, cnt, mine, sp = 0u;
    for (;;) {
        sum = 0u; cnt = 0u; mine = 0u;
#pragma unroll
        for (unsigned j = 0; j < 16; ++j) { const unsigned c = xb_ld(&bar[XB_XCNT(j)]); sum += c; cnt += (c > 0u) ? 1u : 0u; mine = (j == x) ? c : mine; }
        if (sum == G) break;
        __builtin_amdgcn_s_sleep(1);
        if ((++sp & 255u) == 0u) { if (xb_ld(&bar[XB_TMO])) break; if (sp > XB_SPIN_CAP) { atomicAdd(&bar[XB_TMO], 1u); break; } }
    }
    nloc = mine > 0u ? mine : 1u; nx = cnt > 0u ? cnt : 1u;
}
__device__ __forceinline__ void xcd_barrier(unsigned* bar, volatile LAS unsigned* st) {
    asm volatile("s_waitcnt vmcnt(0)" ::: "memory");
    __syncthreads();
    if (threadIdx.x == 0) {
        const unsigned x = xb_xcc_id();
        __builtin_amdgcn_s_waitcnt(0);
        unsigned nloc = st[0], nx = st[1];
        if (nloc == 0u) { xcd_barrier_complete(bar, x, nloc, nx); st[0] = nloc; st[1] = nx; }
        const unsigned old = xb_add(&bar[XB_XSUB(x)], 1u);
        const unsigned gen = old / nloc;
        if (old + 1u == (gen + 1u) * nloc) {
            __builtin_amdgcn_fence(__ATOMIC_RELEASE, "agent");
            asm volatile("s_waitcnt vmcnt(0)" ::: "memory");
            const unsigned og = xb_add(&bar[XB_TOP], 1u);
            const unsigned tg = og / nx;
            if (og + 1u == (tg + 1u) * nx) xb_add(&bar[XB_TOPGEN], 1u);
            else XB_SPIN(xb_ld(&bar[XB_TOPGEN]) == tg, bar);
            __builtin_amdgcn_fence(__ATOMIC_ACQUIRE, "agent");
            xb_add(&bar[XB_XGEN(x)], 1u);
            asm volatile("s_waitcnt vmcnt(0)" ::: "memory");
        } else {
            XB_SPIN(xb_ld(&bar[XB_XGEN(x)]) == gen, bar);
            __builtin_amdgcn_fence(__ATOMIC_ACQUIRE, "agent");
            asm volatile("s_waitcnt vmcnt(0)" ::: "memory");
        }
    }
    __syncthreads();
}

namespace pg8 {
constexpr int BM = 256, BK = 64, HALF = 128, HTB = HALF * BK * 2, STAGE_BYTES = 8 * HTB, NXCD = 8, WGM = 4;
__device__ __forceinline__ int lds_byte(int r, int c) { const int st = (r >> 4) * 2 + (c >> 5), rr = r & 15, cc = c & 31, ob = rr * 64 + cc * 2; return st * 1024 + (ob ^ (((ob >> 9) & 1) << 5)); }
__device__ __forceinline__ void stage_rc(int b, int& R, int& C) { const int st = b / 1024, sb = b % 1024, swz = sb ^ (((sb >> 9) & 1) << 5); R = (st >> 1) * 16 + swz / 64; C = (st & 1) * 32 + (swz % 64) / 2; }
__device__ __forceinline__ int perm32(int rho) { const int n = rho >> 4, i = rho & 15; return 8 * (i >> 2) + 4 * n + (i & 3); }
struct Unit { int pm, pn; };
struct Gemm { const bf16_t* A; const bf16_t* Bt; int ld, K, nNr; size_t ksb; };
struct StaticOrder {
    int nM, nN, nwg, G, c, nextra;
    int i0, ilim;
    int tailM;
    int pm0;
    __device__ __forceinline__ void init(int M_, int N_, int G_, int c_, int nextra_ = 0) { nM = M_ / BM; nN = N_ / BM; nwg = nM * nN; G = G_; c = c_; nextra = nextra_; i0 = 0; ilim = 1 << 20; tailM = 0; pm0 = 0; }
    __device__ __forceinline__ int total() const { return nwg + nextra + tailM * nN; }
    __device__ __forceinline__ void tile(int wgid, int& pm, int& pn) const {
        { const int q = nwg / NXCD, r = nwg % NXCD, xcd = wgid % NXCD, off = wgid / NXCD; wgid = (xcd < r ? xcd * (q + 1) : r * (q + 1) + (xcd - r) * q) + off; }
        const int nig = WGM * nN, gid = wgid / nig, fm = gid * WGM, gsz = (nM - fm) < WGM ? (nM - fm) : WGM;
        pm = fm + ((wgid % nig) % gsz); pn = (wgid % nig) / gsz;
    }
    __device__ __forceinline__ bool next(int i, Unit& u) const {
        const int ii = i + i0; if (ii >= ilim) return false;
        const long L = (long)ii * G + c; if (L >= total()) return false;
        if (L >= nwg && tailM > 0) { const int x = (int)L - nwg; u.pm = pm0 + nM + x % tailM; u.pn = x / tailM; return true; }
        if (L >= nwg) { const int x = (int)L - nwg; u.pm = nM; u.pn = x < 8 ? 4 + x : 20; return true; }
        tile((int)L, u.pm, u.pn); u.pm += pm0; return true;
    }
};

template <class Epi>
__device__ __forceinline__ void gemm_phase(LAS unsigned char* lds, const Gemm g, const StaticOrder& S, const Epi& E) {
    const int tid = ltid(), wid = __builtin_amdgcn_readfirstlane(tid >> 6), lane = tid & 63, wr = wid >> 2, wc = wid & 3, fr = lane & 15, fq = lane >> 4;
    const int K = g.K, nt = K / BK;
    const int ld = g.ld;
    unsigned voffA[2], voffB[2];
#pragma unroll
    for (int i = 0; i < 2; ++i) { int R, C; stage_rc(tid * 16 + i * 8192, R, C); const int Rb = Epi::PERM ? ((R & ~31) + perm32(R & 31)) : R;
        voffA[i] = (unsigned)(R * ld + C) * 2u; voffB[i] = (unsigned)(Rb * ld + C) * 2u; }
    const size_t kstep = (size_t)(BK * 2);
    const size_t hstep = (size_t)HALF * ld * 2;
    const size_t tstep = 2 * hstep;
    const unsigned ldsw = (unsigned)wid * 1024u;
    const int aoff = lds_byte(wr * 64 + fr, fq * 8), boff = lds_byte(wc * 32 + fr, fq * 8);
#define PG8_SA(b, h) (((b) * 2 + (h)) * HTB)
#define PG8_SB(b, h) ((4 + (b) * 2 + (h)) * HTB)
#define PG8_STAGE(bufoff, gbase, voff) do { _Pragma("unroll") for (int _i = 0; _i < 2; ++_i) \
        __builtin_amdgcn_global_load_lds((const unsigned*)((const char*)(gbase) + (voff)[_i]), (LAS unsigned*)(lds + (bufoff) + ldsw + _i * 8192), 16, 0, 0); } while (0)
#define PG8_LDA(dst, b, h) do { _Pragma("unroll") for (int m = 0; m < 4; ++m) _Pragma("unroll") for (int k = 0; k < 2; ++k) dst[m][k] = *(const LAS bf16x8*)(lds + PG8_SA(b, h) + aoff + m * 2048 + k * 1024); } while (0)
#define PG8_LDB(dst, b, h) do { _Pragma("unroll") for (int n = 0; n < 2; ++n) _Pragma("unroll") for (int k = 0; k < 2; ++k) dst[n][k] = *(const LAS bf16x8*)(lds + PG8_SB(b, h) + boff + n * 2048 + k * 1024); } while (0)
#define PG8_MMA(ai, bj, At, Bt) do { __builtin_amdgcn_s_setprio(1); _Pragma("unroll") for (int m = 0; m < 4; ++m) _Pragma("unroll") for (int n = 0; n < 2; ++n) _Pragma("unroll") for (int k = 0; k < 2; ++k) \
        acc[ai][bj][m][n] = __builtin_amdgcn_mfma_f32_16x16x32_bf16(Bt[n][k], At[m][k], acc[ai][bj][m][n], 0, 0, 0); __builtin_amdgcn_s_setprio(0); } while (0)
#define PG8_WAIT_V(n) asm volatile("s_waitcnt vmcnt(" #n ")" ::: "memory")
#define PG8_WAIT_L(n) asm volatile("s_waitcnt lgkmcnt(" #n ")" ::: "memory")
#define PG8_BAR __builtin_amdgcn_s_barrier()
#define PG8_SCHED __builtin_amdgcn_sched_barrier(0)
    Unit cur, nxt; int ui = 0;
    if (!S.next(0, cur)) return;
    f32x4 acc[2][2][4][2];
#pragma unroll
    for (int a = 0; a < 2; ++a)
#pragma unroll
        for (int b = 0; b < 2; ++b)
#pragma unroll
            for (int m = 0; m < 4; ++m)
#pragma unroll
                for (int n = 0; n < 2; ++n) acc[a][b][m][n] = (f32x4){0.f, 0.f, 0.f, 0.f};
    bf16x8 At[4][2], B0[2][2], B1[2][2];
#define PG8_APTR(u) ((const char*)g.A + (size_t)(u).pm * tstep + (size_t)((u).pn / g.nNr) * g.ksb)
#define PG8_BPTR(u) ((const char*)g.Bt + (size_t)((u).pn % g.nNr) * tstep + (size_t)((u).pn / g.nNr) * g.ksb)
    const char* cA = PG8_APTR(cur); const char* cB = PG8_BPTR(cur);
    PG8_STAGE(PG8_SB(0, 0), cB, voffB); PG8_STAGE(PG8_SA(0, 0), cA, voffA); PG8_STAGE(PG8_SB(0, 1), cB + hstep, voffB); PG8_STAGE(PG8_SA(0, 1), cA + hstep, voffA);
    if (wr == 1) PG8_BAR;
    PG8_WAIT_V(4); PG8_BAR;
    PG8_STAGE(PG8_SB(1, 0), cB + kstep, voffB); PG8_STAGE(PG8_SA(1, 0), cA + kstep, voffA); PG8_STAGE(PG8_SB(1, 1), cB + hstep + kstep, voffB);
    PG8_WAIT_V(6); PG8_BAR;
    for (;;) {
        const bool has_next = S.next(ui + 1, nxt);
        const char* nA = has_next ? PG8_APTR(nxt) : cA; const char* nB = has_next ? PG8_BPTR(nxt) : cB;
        for (int t = 0; t < nt; t += 2) {
            const bool last = (t == nt - 2);
            const char* a1 = cA + (size_t)(t + 1) * kstep;
            const char* a2 = last ? nA : cA + (size_t)(t + 2) * kstep; const char* b2 = last ? nB : cB + (size_t)(t + 2) * kstep;
            const char* a3 = a2 + kstep; const char* b3 = b2 + kstep;
            PG8_LDB(B0, 0, 0); PG8_SCHED; PG8_LDA(At, 0, 0); PG8_STAGE(PG8_SA(1, 1), a1 + hstep, voffA);
            PG8_WAIT_L(8); PG8_BAR; PG8_WAIT_L(0); PG8_MMA(0, 0, At, B0); PG8_BAR; PG8_SCHED;
            PG8_LDB(B1, 0, 1); PG8_STAGE(PG8_SB(0, 0), b2, voffB);
            PG8_BAR; PG8_WAIT_L(0); PG8_MMA(0, 1, At, B1); PG8_BAR;
            PG8_LDA(At, 0, 1); PG8_STAGE(PG8_SA(0, 0), a2, voffA);
            PG8_BAR; PG8_WAIT_L(0); PG8_MMA(1, 0, At, B0); PG8_BAR; PG8_SCHED;
            PG8_STAGE(PG8_SB(0, 1), b2 + hstep, voffB);
            PG8_WAIT_V(6); PG8_BAR; PG8_MMA(1, 1, At, B1); PG8_BAR;
            PG8_LDB(B0, 1, 0); PG8_SCHED; PG8_LDA(At, 1, 0); PG8_STAGE(PG8_SA(0, 1), a2 + hstep, voffA);
            PG8_WAIT_L(8); PG8_BAR; PG8_WAIT_L(0); PG8_MMA(0, 0, At, B0); PG8_BAR; PG8_SCHED;
            PG8_LDB(B1, 1, 1); PG8_STAGE(PG8_SB(1, 0), b3, voffB);
            PG8_BAR; PG8_WAIT_L(0); PG8_MMA(0, 1, At, B1); PG8_BAR;
            PG8_LDA(At, 1, 1); PG8_STAGE(PG8_SA(1, 0), a3, voffA);
            PG8_BAR; PG8_WAIT_L(0); PG8_MMA(1, 0, At, B0); PG8_BAR; PG8_SCHED;
            PG8_STAGE(PG8_SB(1, 1), b3 + hstep, voffB);
            PG8_WAIT_V(6); PG8_BAR; PG8_MMA(1, 1, At, B1); PG8_BAR;
        }
        E(acc, cur, wr, wc, fr, fq);
        if (!has_next) break;
#pragma unroll
        for (int a = 0; a < 2; ++a)
#pragma unroll
            for (int b = 0; b < 2; ++b)
#pragma unroll
                for (int m = 0; m < 4; ++m)
#pragma unroll
                    for (int n = 0; n < 2; ++n) acc[a][b][m][n] = (f32x4){0.f, 0.f, 0.f, 0.f};
        cur = nxt; cA = nA; cB = nB; ++ui;
    }
    PG8_WAIT_V(0);
    if (wr == 0) PG8_BAR;
    PG8_BAR;
#undef PG8_APTR
#undef PG8_BPTR
#undef PG8_SA
#undef PG8_SB
#undef PG8_STAGE
#undef PG8_LDA
#undef PG8_LDB
#undef PG8_MMA
#undef PG8_WAIT_V
#undef PG8_WAIT_L
#undef PG8_BAR
#undef PG8_SCHED
}
}

struct EpiIn {
    static constexpr bool PERM = true;
    bf16_t* Z; const float* cosR; const float* sinR; const float* cosS; const float* sinS; float* out;
    __device__ __forceinline__ void operator()(const f32x4 (&acc)[2][2][4][2], const pg8::Unit& u, int wr, int wc, int fr, int fq) const {
        const int pn = u.pn;
#pragma unroll
        for (int ai = 0; ai < 2; ++ai) {
            f32x4 tc0[4], tc1[4], ts0[4], ts1[4];
            if (pn < 8 || pn >= 16) {
#pragma unroll
                for (int m = 0; m < 4; ++m) {
                    const int row = u.pm * 256 + ai * 128 + wr * 64 + m * 16 + fr; int tab = 0;
                    if (row < SROW) tab = 16 + (row & 2047); else if (row < MR) tab = LP + ((row - SROW) & 7); else if (row < M) tab = (row - METAROW) & 15;
                    const float* cp_ = pn < 8 ? cosR + tab * 128 + wc * 32 + 8 * fq : cosS + tab * 8;
                    const float* sp_ = pn < 8 ? sinR + tab * 128 + wc * 32 + 8 * fq : sinS + tab * 8;
                    tc0[m] = *(const f32x4*)cp_; tc1[m] = *(const f32x4*)(cp_ + 4); ts0[m] = *(const f32x4*)sp_; ts1[m] = *(const f32x4*)(sp_ + 4);
                }
            }
#pragma unroll
            for (int m = 0; m < 4; ++m) {
                const int row = u.pm * 256 + ai * 128 + wr * 64 + m * 16 + fr;
                int b = 0, t = 0, tab = 0; const bool isP = row < SROW || (row >= METAROW && row < M), isS = (row >= SROW) && (row < MR);
                if (row < SROW) { b = row >> 11; t = 16 + (row & 2047); tab = t; } else if (isS) { const int s = row - SROW; b = s >> 3; t = s & 7; tab = LP + t; }
                else if (isP) { const int mrow = row - METAROW; b = mrow >> 4; t = mrow & 15; tab = t; }
                f32x4 o00 = acc[ai][0][m][0], o01 = acc[ai][0][m][1], o10 = acc[ai][1][m][0], o11 = acc[ai][1][m][1];
                if (pn < 8) {
                    const f32x4 c0 = tc0[m], c1 = tc1[m], s0 = ts0[m], s1 = ts1[m];
                    const float sc = pn >= 4 ? 0.0625f : 1.0f;
                    const f32x4 a0 = o00, a1 = o01, b0 = o10, b1 = o11;
                    o00 = (a0 * c0 - b0 * s0) * sc; o10 = (b0 * c0 + a0 * s0) * sc;
                    o01 = (a1 * c1 - b1 * s1) * sc; o11 = (b1 * c1 + a1 * s1) * sc;
                } else if (pn < 12) {
                } else if (pn < 16) {
#pragma unroll
                    for (int j = 0; j < 4; ++j) { o00[j] = silu(o00[j]); o01[j] = silu(o01[j]); o10[j] = silu(o10[j]); o11[j] = silu(o11[j]); }
                } else {
                    const f32x4 c0 = tc0[m], c1 = tc1[m], s0 = ts0[m], s1 = ts1[m];
                    const bool rot = ((wc & 1) == 0) && (fq < 2); const float sg = fq == 0 ? -1.f : 1.f;
                    f32x4 p;
#pragma unroll
                    for (int j = 0; j < 4; ++j) p[j] = __shfl_xor(o00[j], 16);
                    if (rot) o00 = o00 * c0 + p * s0 * sg;
#pragma unroll
                    for (int j = 0; j < 4; ++j) p[j] = __shfl_xor(o01[j], 16);
                    if (rot) o01 = o01 * c1 + p * s1 * sg;
                    if (pn < 20) {
#pragma unroll
                        for (int j = 0; j < 4; ++j) p[j] = __shfl_xor(o10[j], 16);
                        if (rot) o10 = o10 * c0 + p * s0 * sg;
#pragma unroll
                        for (int j = 0; j < 4; ++j) p[j] = __shfl_xor(o11[j], 16);
                        if (rot) o11 = o11 * c1 + p * s1 * sg;
                        o00 *= 0.125f; o01 *= 0.125f; o10 *= 0.125f; o11 *= 0.125f;
                    } else {
                        const int cc = wc * 32 + 8 * fq;
                        if (isP && t >= LP - 128) {
                            float* kp = out + OFF_KP + ((size_t)(b * 128 + (t - (LP - 128))) * 128 + cc);
                            float* vp = out + OFF_VP + ((size_t)(b * 128 + (t - (LP - 128))) * 128 + cc);
                            *(f32x4*)kp = o00; *(f32x4*)(kp + 4) = o01; *(f32x4*)vp = o10; *(f32x4*)(vp + 4) = o11;
                        } else if (isS) {
                            float* kp = out + OFF_KS + ((size_t)(b * 128 + 120 + t) * 128 + cc);
                            float* vp = out + OFF_VS + ((size_t)(b * 128 + 120 + t) * 128 + cc);
                            *(f32x4*)kp = o00; *(f32x4*)(kp + 4) = o01; *(f32x4*)vp = o10; *(f32x4*)(vp + 4) = o11;
                        }
                    }
                }
                bf16_t* zrow = Z + (size_t)row * PW + pn * 256 + wc * 32 + 8 * fq;
                u32x4 w0, w1;
                w0.x = cvt_pk_bf16(o00[0], o00[1]); w0.y = cvt_pk_bf16(o00[2], o00[3]); w0.z = cvt_pk_bf16(o01[0], o01[1]); w0.w = cvt_pk_bf16(o01[2], o01[3]);
                w1.x = cvt_pk_bf16(o10[0], o10[1]); w1.y = cvt_pk_bf16(o10[2], o10[3]); w1.z = cvt_pk_bf16(o11[0], o11[1]); w1.w = cvt_pk_bf16(o11[2], o11[3]);
                *(u32x4*)zrow = w0; *(u32x4*)(zrow + 128) = w1;
            }
        }
    }
};
struct EpiRes {
    static constexpr bool PERM = true;
    bf16_t* PRE; const bf16_t* R; bf16_t* PRE2;
    __device__ __forceinline__ void operator()(const f32x4 (&acc)[2][2][4][2], const pg8::Unit& u, int wr, int wc, int fr, int fq) const {
        const bool second = u.pn >= 8; const int pn = u.pn & 7; bf16_t* dst = second ? PRE2 : PRE;
        u32x4 rr[2][4][2];
        if (!second) {
#pragma unroll
            for (int ai = 0; ai < 2; ++ai)
#pragma unroll
                for (int m = 0; m < 4; ++m)
#pragma unroll
                    for (int bj = 0; bj < 2; ++bj) rr[ai][m][bj] = *(const u32x4*)(R + (size_t)(u.pm * 256 + ai * 128 + wr * 64 + m * 16 + fr) * D + pn * 256 + wc * 32 + 8 * fq + bj * 128);
        }
#pragma unroll
        for (int ai = 0; ai < 2; ++ai)
#pragma unroll
            for (int m = 0; m < 4; ++m) {
                const size_t off = (size_t)(u.pm * 256 + ai * 128 + wr * 64 + m * 16 + fr) * D + pn * 256 + wc * 32 + 8 * fq;
#pragma unroll
                for (int bj = 0; bj < 2; ++bj) {
                    f32x4 o0 = acc[ai][bj][m][0], o1 = acc[ai][bj][m][1];
                    if (!second) {
                        const u32x4 r = rr[ai][m][bj];
                        o0 += (f32x4){bf2f(r.x & 0xffffu), bf2f(r.x >> 16), bf2f(r.y & 0xffffu), bf2f(r.y >> 16)} * ALPHA;
                        o1 += (f32x4){bf2f(r.z & 0xffffu), bf2f(r.z >> 16), bf2f(r.w & 0xffffu), bf2f(r.w >> 16)} * ALPHA;
                    }
                    u32x4 w; w.x = cvt_pk_bf16(o0[0], o0[1]); w.y = cvt_pk_bf16(o0[2], o0[3]); w.z = cvt_pk_bf16(o1[0], o1[1]); w.w = cvt_pk_bf16(o1[2], o1[3]);
                    *(u32x4*)(dst + off + bj * 128) = w;
                }
            }
    }
};
typedef float f32x2 __attribute__((ext_vector_type(2)));
__device__ __forceinline__ f32x2 glu_pk(f32x2 g, f32x2 u) {
    const f32x2 t = g * (-1.4426950408889634f);
    f32x2 e; e.x = __builtin_amdgcn_exp2f(t.x); e.y = __builtin_amdgcn_exp2f(t.y);
    const f32x2 d = e + 1.0f;
    f32x2 r; r.x = __builtin_amdgcn_rcpf(d.x); r.y = __builtin_amdgcn_rcpf(d.y);
    return (g * u) * r;
}
struct EpiGlu {
    static constexpr bool PERM = true;
    bf16_t* A2;
    __device__ __forceinline__ void operator()(const f32x4 (&acc)[2][2][4][2], const pg8::Unit& u, int wr, int wc, int fr, int fq) const {
#pragma unroll
        for (int ai = 0; ai < 2; ++ai)
#pragma unroll
            for (int m = 0; m < 4; ++m) {
                const size_t off = (size_t)(u.pm * 256 + ai * 128 + wr * 64 + m * 16 + fr) * FF + u.pn * 128 + wc * 32 + 8 * fq;
                const f32x4 g0 = acc[ai][0][m][0], g1 = acc[ai][0][m][1], u0 = acc[ai][1][m][0], u1 = acc[ai][1][m][1];
                const f32x2 a = glu_pk((f32x2){g0[0], g0[1]}, (f32x2){u0[0], u0[1]}), b = glu_pk((f32x2){g0[2], g0[3]}, (f32x2){u0[2], u0[3]});
                const f32x2 c = glu_pk((f32x2){g1[0], g1[1]}, (f32x2){u1[0], u1[1]}), d = glu_pk((f32x2){g1[2], g1[3]}, (f32x2){u1[2], u1[3]});
                u32x4 w; w.x = cvt_pk_bf16(a.x, a.y); w.y = cvt_pk_bf16(b.x, b.y); w.z = cvt_pk_bf16(c.x, c.y); w.w = cvt_pk_bf16(d.x, d.y);
                *(u32x4*)(A2 + off) = w;
            }
    }
};

__device__ __forceinline__ void transpose_item(const float* W, int K, int N, bf16_t* WT, int k0, int n0, int drow, float* scr, int lane) {
    f32x4 v[16];
#pragma unroll
    for (int i = 0; i < 16; ++i) { const int kk = 4 * i + (lane >> 4), c4 = lane & 15; v[i] = __builtin_nontemporal_load((const f32x4*)(W + (size_t)(k0 + kk) * N + n0 + 4 * c4)); }
#pragma unroll
    for (int i = 0; i < 16; ++i) {
        const int kk = 4 * i + (lane >> 4), c4 = lane & 15;
        float* s = scr + kk * 65 + 4 * c4; s[0] = v[i][0]; s[1] = v[i][1]; s[2] = v[i][2]; s[3] = v[i][3];
    }
    asm volatile("s_waitcnt lgkmcnt(0)" ::: "memory");
    const int c = lane & 7;
#pragma unroll
    for (int jn = 0; jn < 8; ++jn) {
        const int n = (lane >> 3) + 8 * jn; const float* s = scr + (8 * c) * 65 + n;
        u32x4 o; o.x = cvt_pk_bf16(s[0], s[65]); o.y = cvt_pk_bf16(s[130], s[195]); o.z = cvt_pk_bf16(s[260], s[325]); o.w = cvt_pk_bf16(s[390], s[455]);
        *(u32x4*)(WT + (size_t)(drow + n) * K + k0 + 8 * c) = o;
    }
    asm volatile("s_waitcnt lgkmcnt(0)" ::: "memory");
}
template <bool OUTF, bool TWO = false, class TI = float>
__device__ __forceinline__ void ln_row(const TI* xrow, const float* g, const float* bta, void* orow, int lane, const TI* xrow2 = nullptr) {
    f32x4 v[8]; float s = 0.f;
#pragma unroll
    for (int j = 0; j < 8; ++j) { v[j] = ld4(xrow, 64 * j + lane); if (TWO) v[j] += ld4(xrow2, 64 * j + lane); s += (v[j][0] + v[j][1]) + (v[j][2] + v[j][3]); }
    const float mean = wave_sum(s) * (1.f / D); float s2 = 0.f;
#pragma unroll
    for (int j = 0; j < 8; ++j) { v[j] = v[j] - mean; s2 += (v[j][0] * v[j][0] + v[j][1] * v[j][1]) + (v[j][2] * v[j][2] + v[j][3] * v[j][3]); }
    const float rstd = 1.f / sqrtf(wave_sum(s2) * (1.f / D) + LN_EPS);
#pragma unroll
    for (int j = 0; j < 8; ++j) {
        const f32x4 gg = ((const f32x4*)g)[64 * j + lane], bb = ((const f32x4*)bta)[64 * j + lane];
        const f32x4 y = v[j] * rstd * gg + bb;
        if (OUTF) ((f32x4*)orow)[64 * j + lane] = y;
        else { u32x2 w; w.x = cvt_pk_bf16(y[0], y[1]); w.y = cvt_pk_bf16(y[2], y[3]); ((u32x2*)orow)[64 * j + lane] = w; }
    }
}
template <bool OUTF>
__device__ __forceinline__ void ln2_bf16(const bf16_t* xa0, const bf16_t* xa1, const bf16_t* xb0, const bf16_t* xb1, bool hasB,
                                         const float* g, const float* bta, void* oa, void* ob, int lane) {
    u32x4 ra0[4], ra1[4], rb0[4], rb1[4]; f32x4 gg[8], bb[8];
#pragma unroll
    for (int j = 0; j < 4; ++j) { ra0[j] = ((const u32x4*)xa0)[64 * j + lane]; ra1[j] = ((const u32x4*)xa1)[64 * j + lane]; rb0[j] = ((const u32x4*)xb0)[64 * j + lane]; rb1[j] = ((const u32x4*)xb1)[64 * j + lane]; }
#pragma unroll
    for (int j = 0; j < 4; ++j) { gg[2 * j] = ((const f32x4*)g)[2 * (64 * j + lane)]; gg[2 * j + 1] = ((const f32x4*)g)[2 * (64 * j + lane) + 1];
                                  bb[2 * j] = ((const f32x4*)bta)[2 * (64 * j + lane)]; bb[2 * j + 1] = ((const f32x4*)bta)[2 * (64 * j + lane) + 1]; }
    f32x4 va[8], vb[8]; float sa = 0.f, sb = 0.f;
#pragma unroll
    for (int j = 0; j < 4; ++j) {
        f32x4 l0, h0, l1, h1;
        unpack8(ra0[j], l0, h0); unpack8(ra1[j], l1, h1); va[2 * j] = l0 + l1; va[2 * j + 1] = h0 + h1;
        unpack8(rb0[j], l0, h0); unpack8(rb1[j], l1, h1); vb[2 * j] = l0 + l1; vb[2 * j + 1] = h0 + h1;
    }
#pragma unroll
    for (int k = 0; k < 8; ++k) { sa += (va[k][0] + va[k][1]) + (va[k][2] + va[k][3]); sb += (vb[k][0] + vb[k][1]) + (vb[k][2] + vb[k][3]); }
    const float ma = wave_sum(sa) * (1.f / D), mb = wave_sum(sb) * (1.f / D); float qa = 0.f, qb = 0.f;
#pragma unroll
    for (int k = 0; k < 8; ++k) { va[k] = va[k] - ma; vb[k] = vb[k] - mb;
        qa += (va[k][0] * va[k][0] + va[k][1] * va[k][1]) + (va[k][2] * va[k][2] + va[k][3] * va[k][3]);
        qb += (vb[k][0] * vb[k][0] + vb[k][1] * vb[k][1]) + (vb[k][2] * vb[k][2] + vb[k][3] * vb[k][3]); }
    const float ra = 1.f / sqrtf(wave_sum(qa) * (1.f / D) + LN_EPS), rb = 1.f / sqrtf(wave_sum(qb) * (1.f / D) + LN_EPS);
#pragma unroll
    for (int j = 0; j < 4; ++j) {
        const f32x4 ya0 = va[2 * j] * ra * gg[2 * j] + bb[2 * j], ya1 = va[2 * j + 1] * ra * gg[2 * j + 1] + bb[2 * j + 1];
        const f32x4 yb0 = vb[2 * j] * rb * gg[2 * j] + bb[2 * j], yb1 = vb[2 * j + 1] * rb * gg[2 * j + 1] + bb[2 * j + 1];
        if (OUTF) {
            ((f32x4*)oa)[2 * (64 * j + lane)] = ya0; ((f32x4*)oa)[2 * (64 * j + lane) + 1] = ya1;
            if (hasB) { ((f32x4*)ob)[2 * (64 * j + lane)] = yb0; ((f32x4*)ob)[2 * (64 * j + lane) + 1] = yb1; }
        } else {
            u32x4 w; w.x = cvt_pk_bf16(ya0[0], ya0[1]); w.y = cvt_pk_bf16(ya0[2], ya0[3]); w.z = cvt_pk_bf16(ya1[0], ya1[1]); w.w = cvt_pk_bf16(ya1[2], ya1[3]);
            ((u32x4*)oa)[64 * j + lane] = w;
            if (hasB) { u32x4 x; x.x = cvt_pk_bf16(yb0[0], yb0[1]); x.y = cvt_pk_bf16(yb0[2], yb0[3]); x.z = cvt_pk_bf16(yb1[0], yb1[1]); x.w = cvt_pk_bf16(yb1[2], yb1[3]);
                ((u32x4*)ob)[64 * j + lane] = x; }
        }
    }
}
__device__ __forceinline__ void ln2_f32(const float* xa, const float* xb, bool hasB, const float* g, const float* bta, bf16_t* oa, bf16_t* ob, int lane) {
    f32x4 va[8], vb[8]; float sa = 0.f, sb = 0.f;
#pragma unroll
    for (int j = 0; j < 8; ++j) { va[j] = __builtin_nontemporal_load((const f32x4*)xa + 64 * j + lane); vb[j] = __builtin_nontemporal_load((const f32x4*)xb + 64 * j + lane); }
#pragma unroll
    for (int j = 0; j < 8; ++j) { sa += (va[j][0] + va[j][1]) + (va[j][2] + va[j][3]); sb += (vb[j][0] + vb[j][1]) + (vb[j][2] + vb[j][3]); }
    const float ma = wave_sum(sa) * (1.f / D), mb = wave_sum(sb) * (1.f / D); float qa = 0.f, qb = 0.f;
#pragma unroll
    for (int j = 0; j < 8; ++j) { va[j] = va[j] - ma; vb[j] = vb[j] - mb;
        qa += (va[j][0] * va[j][0] + va[j][1] * va[j][1]) + (va[j][2] * va[j][2] + va[j][3] * va[j][3]);
        qb += (vb[j][0] * vb[j][0] + vb[j][1] * vb[j][1]) + (vb[j][2] * vb[j][2] + vb[j][3] * vb[j][3]); }
    const float ra = 1.f / sqrtf(wave_sum(qa) * (1.f / D) + LN_EPS), rb = 1.f / sqrtf(wave_sum(qb) * (1.f / D) + LN_EPS);
#pragma unroll
    for (int j = 0; j < 8; ++j) {
        const f32x4 gg = ((const f32x4*)g)[64 * j + lane], bb = ((const f32x4*)bta)[64 * j + lane];
        const f32x4 ya = va[j] * ra * gg + bb, yb = vb[j] * rb * gg + bb;
        u32x2 w; w.x = cvt_pk_bf16(ya[0], ya[1]); w.y = cvt_pk_bf16(ya[2], ya[3]); ((u32x2*)oa)[64 * j + lane] = w;
        if (hasB) { u32x2 x; x.x = cvt_pk_bf16(yb[0], yb[1]); x.y = cvt_pk_bf16(yb[2], yb[3]); ((u32x2*)ob)[64 * j + lane] = x; }
    }
}
__device__ __forceinline__ void sincos_d(float ang, float& c, float& s) {
    const double a = (double)ang; const double k = rint(a * 0.63661977236758134308);
    double r = fma(-k, 1.5707963267948966192, a); r = fma(-k, 6.123233995736766e-17, r);
    const int q = ((int)k) & 3; const double r2 = r * r;
    const double sp = r * (1.0 + r2 * (-1.0 / 6.0 + r2 * (1.0 / 120.0 + r2 * (-1.0 / 5040.0 + r2 * (1.0 / 362880.0 + r2 * (-1.0 / 39916800.0 + r2 * (1.0 / 6227020800.0)))))));
    const double cp = 1.0 + r2 * (-0.5 + r2 * (1.0 / 24.0 + r2 * (-1.0 / 720.0 + r2 * (1.0 / 40320.0 + r2 * (-1.0 / 3628800.0 + r2 * (1.0 / 479001600.0 + r2 * (-1.0 / 87178291200.0)))))));
    const double ss = (q == 0) ? sp : (q == 1) ? cp : (q == 2) ? -sp : -cp;
    const double cc = (q == 0) ? cp : (q == 1) ? -sp : (q == 2) ? -cp : sp;
    c = (float)cc; s = (float)ss;
}
__device__ __forceinline__ double dpowi(double base, int n) { double r = 1.0, b = base; for (int i = 0; i < 8; ++i) { if (n & 1) r *= b; b *= b; n >>= 1; } return r; }

__device__ __forceinline__ void late_transposes(KArgs a, unsigned char* lds, int tid, int gw, int NGW) {
    const int wave = tid >> 6, lane = tid & 63;
    unsigned char* ws = a->ws;
    float* scr = (float*)(lds + wave * 16896);
    constexpr int I_G = 32 * 88, I_D = 88 * 32;
    for (int it = gw; it < 2 * I_G + I_D; it += NGW) {
        int r = it;
        if (r < I_G) { const int kb = r / 88, nb = r % 88; const int n0 = 64 * nb; transpose_item(a->in[13], D, FF, (bf16_t*)(ws + WS_WGU), 64 * kb, n0, 256 * (n0 >> 7) + (n0 & 127), scr, lane); continue; } r -= I_G;
        if (r < I_G) { const int kb = r / 88, nb = r % 88; const int n0 = 64 * nb; transpose_item(a->in[14], D, FF, (bf16_t*)(ws + WS_WGU), 64 * kb, n0, 256 * (n0 >> 7) + 128 + (n0 & 127), scr, lane); continue; } r -= I_G;
        { const int kb = r / 32, nb = r % 32; transpose_item(a->in[15], FF, D, (bf16_t*)(ws + WS_WD), 64 * kb, 64 * nb, 64 * nb, scr, lane); }
    }
}

__device__ __forceinline__ void phase0(KArgs a, unsigned char* lds, int tid, int G) {
    const int wave = tid >> 6, lane = tid & 63;
    const int gw = blockIdx.x * 8 + wave, NGW = G * 8;
    unsigned char* ws = a->ws;
    float* scr = (float*)(lds + wave * 16896);
    for (int it = gw; it < 32 * 84 + 32 * 32; it += NGW) {
        if (it < 32 * 84) { const int kb = it / 84, nb = it % 84; transpose_item(a->in[8], D, PW, (bf16_t*)(ws + WS_WIN), 64 * kb, 64 * nb, 64 * nb, scr, lane); }
        else { const int r = it - 32 * 84, kb = r / 32, nb = r % 32; transpose_item(a->in[9], D, D, (bf16_t*)(ws + WS_WO), 64 * kb, 64 * nb, 64 * nb, scr, lane); }
    }
    bf16_t* H = (bf16_t*)(ws + WS_H); bf16_t* MIX = (bf16_t*)(ws + WS_MIX);
    for (int row = M + gw; row < MPAD; row += NGW) {
        const u32x4 z = (u32x4){0u, 0u, 0u, 0u};
#pragma unroll
        for (int j = 0; j < 4; ++j) { ((u32x4*)(H + (size_t)row * D))[64 * j + lane] = z; ((u32x4*)(MIX + (size_t)row * D))[64 * j + lane] = z; }
    }
    for (int row = gw; row < M; row += 2 * NGW) {
        const int rowb = row + NGW; const bool hasB = rowb < M; const int rb = hasB ? rowb : row;
        const float* sa = row < SROW ? a->in[0] + (size_t)row * D : row < MR ? a->in[1] + (size_t)(row - SROW) * D : a->in[5] + (size_t)((row - METAROW) & 15) * D;
        const float* sb = rb < SROW ? a->in[0] + (size_t)rb * D : rb < MR ? a->in[1] + (size_t)(rb - SROW) * D : a->in[5] + (size_t)((rb - METAROW) & 15) * D;
        ln2_f32(sa, sb, hasB, a->in[6], a->in[7], H + (size_t)row * D, H + (size_t)rb * D, lane);
    }
    float* cosR = (float*)(ws + WS_TAB); float* sinR = cosR + NPOS * 128; float* cosS = sinR + NPOS * 128; float* sinS = cosS + NPOS * 8;
    const int gt = blockIdx.x * 512 + tid, NGT = G * 512;
    for (int i = gt; i < NPOS * 128; i += NGT) {
        const int pi = i >> 7, f = i & 127; const int pos = pi < LP ? pi : 16384 + (pi - LP);
        const float inv = (float)dpowi(0.9300449458481392, f);
        float c, s; sincos_d((float)pos * inv, c, s); cosR[i] = c; sinR[i] = s;
    }
    for (int i = gt; i < NPOS * 8; i += NGT) {
        const int pi = i >> 3, f = i & 7; const int pos = pi < LP ? pi : 16384 + (pi - LP);
        const float inv = (float)dpowi(0.19392274474868576, f);
        float c, s; sincos_d((float)pos * inv, c, s); cosS[i] = c; sinS[i] = s;
    }
    for (int i0 = gt; i0 < 128 * 120 * 32; i0 += 4 * NGT) {
        f32x4 kv[4], vv[4];
#pragma unroll
        for (int u = 0; u < 4; ++u) { const int i = i0 + u * NGT; if (i < 128 * 120 * 32) { const int b = i / (120 * 32), rem = i - b * (120 * 32); const size_t so = (size_t)b * 128 * 128 + 8 * 128 + (size_t)rem * 4;
            kv[u] = __builtin_nontemporal_load((const f32x4*)(a->in[3] + so)); vv[u] = __builtin_nontemporal_load((const f32x4*)(a->in[4] + so)); } }
#pragma unroll
        for (int u = 0; u < 4; ++u) { const int i = i0 + u * NGT; if (i < 128 * 120 * 32) { const int b = i / (120 * 32), rem = i - b * (120 * 32); const size_t dst = (size_t)b * 128 * 128 + (size_t)rem * 4;
            *(f32x4*)(a->out + OFF_KS + dst) = kv[u]; *(f32x4*)(a->out + OFF_VS + dst) = vv[u]; } }
    }
}

__device__ __forceinline__ void retA_item(unsigned char* lds, const bf16_t* Z, bf16_t* U, int item, int tid) {
    asm volatile("" : "+v"(tid));
    const int bh = item < 256 ? (item >> 4) : (item - 256), c = item < 256 ? 1 + (item & 15) : 0, b = bh >> 2, h = bh & 3;
    const int C = c == 0 ? 16 : 128, tok0 = c == 0 ? 0 : 16 + 128 * (c - 1);
    const size_t row0 = c == 0 ? (size_t)METAROW + b * 16 : (size_t)b * 2048 + 128 * (c - 1);
    const int wave = __builtin_amdgcn_readfirstlane(tid >> 6), lane = tid & 63, fr = lane & 15, fq = lane >> 4;
    bf16_t* Vt = (bf16_t*)lds; bf16_t* Kt = (bf16_t*)(lds + 69632);
    const float lg = lg2gamma(h);
    const int dim0 = 8 * (4 * wave + fq);
    {
        u32x4 ka[4], kb[4], va[4], vb[4];
#pragma unroll
        for (int i = 0; i < 4; ++i) {
            const int j0 = 2 * (16 * i + fr);
            ka[i] = (u32x4){0u, 0u, 0u, 0u}; kb[i] = ka[i]; va[i] = ka[i]; vb[i] = ka[i];
            if (j0 < C) { const bf16_t* p = Z + (row0 + j0) * PW + h * 256 + dim0; ka[i] = *(const u32x4*)(p + ZK); va[i] = *(const u32x4*)(p + ZV); }
            if (j0 + 1 < C) { const bf16_t* p = Z + (row0 + j0 + 1) * PW + h * 256 + dim0; kb[i] = *(const u32x4*)(p + ZK); vb[i] = *(const u32x4*)(p + ZV); }
        }
#pragma unroll
        for (int i = 0; i < 4; ++i) {
            const int j0 = 2 * (16 * i + fr);
            const float w0 = fexp2((float)(C - 1 - j0) * lg), w1 = fexp2((float)(C - 2 - j0) * lg);
#pragma unroll
            for (int u = 0; u < 8; ++u) {
                const unsigned wa = ka[i][u >> 1], wb = kb[i][u >> 1], xa = va[i][u >> 1], xb = vb[i][u >> 1];
                const unsigned k_a = (u & 1) ? (wa >> 16) : (wa & 0xffffu), k_b = (u & 1) ? (wb >> 16) : (wb & 0xffffu);
                const unsigned v_a = (u & 1) ? (xa >> 16) : (xa & 0xffffu), v_b = (u & 1) ? (xb >> 16) : (xb & 0xffffu);
                *(unsigned*)(Kt + (dim0 + u) * 136 + j0) = cvt_pk_bf16(bf2f(k_a) * w0, bf2f(k_b) * w1);
                *(unsigned*)(Vt + (dim0 + u) * 136 + j0) = v_a | (v_b << 16);
            }
        }
    }
    __syncthreads();
    const int nks = C == 16 ? 1 : 4;
    bf16_t* Uo = U + (size_t)(bh * 17 + c) * 65536;
#pragma unroll 1
    for (int pass = 0; pass < 2; ++pass) {
        f32x4 acc[2][8];
#pragma unroll
        for (int et = 0; et < 2; ++et)
#pragma unroll
            for (int dt = 0; dt < 8; ++dt) acc[et][dt] = (f32x4){0.f, 0.f, 0.f, 0.f};
#pragma unroll
        for (int ks = 0; ks < 4; ++ks) if (ks < nks) {
            const bf16x8 a0 = *(const bf16x8*)(Vt + (32 * wave + fr) * 136 + 32 * ks + 8 * fq);
            const bf16x8 a1 = *(const bf16x8*)(Vt + (32 * wave + 16 + fr) * 136 + 32 * ks + 8 * fq);
#pragma unroll
            for (int dt = 0; dt < 8; ++dt) {
                const bf16x8 bb = *(const bf16x8*)(Kt + (128 * pass + 16 * dt + fr) * 136 + 32 * ks + 8 * fq);
                acc[0][dt] = mfma16(bb, a0, acc[0][dt]); acc[1][dt] = mfma16(bb, a1, acc[1][dt]);
            }
        }
#pragma unroll
        for (int et = 0; et < 2; ++et)
#pragma unroll
            for (int dt = 0; dt < 8; ++dt)
            { u32x2 w; w.x = cvt_pk_bf16(acc[et][dt][0], acc[et][dt][1]); w.y = cvt_pk_bf16(acc[et][dt][2], acc[et][dt][3]);
              *(u32x2*)(Uo + (32 * wave + 16 * et + fr) * 256 + 128 * pass + 16 * dt + 4 * fq) = w; }
    }
    __syncthreads();
}

__device__ __forceinline__ void ret_scan(const bf16_t* U, bf16_t* Sb, float* out, int tid, int G) {
    for (int idx = blockIdx.x * 512 + tid; idx < 16 * 8192; idx += G * 512) {
        const int bh = idx >> 13, rem = idx & 8191, e = rem >> 5, d8 = (rem & 31) * 8, h = bh & 3;
        const float g128 = fexp2(128.f * lg2gamma(h));
        const bf16_t* Up = U + (size_t)bh * 17 * 65536 + e * 256 + d8;
        bf16_t* Sp = Sb + (size_t)bh * 16 * 65536 + e * 256 + d8;
        u32x4 ur[17];
#pragma unroll
        for (int c = 0; c < 17; ++c) ur[c] = *(const u32x4*)(Up + (size_t)c * 65536);
        f32x4 S0, S1; unpack8(ur[0], S0, S1);
#pragma unroll
        for (int c = 0; c < 17; ++c) {
            if (c > 0) { f32x4 u0, u1; unpack8(ur[c], u0, u1); S0 = S0 * g128 + u0; S1 = S1 * g128 + u1; }
            if (c < 16) { u32x4 w; w.x = cvt_pk_bf16(S0[0], S0[1]); w.y = cvt_pk_bf16(S0[2], S0[3]); w.z = cvt_pk_bf16(S1[0], S1[1]); w.w = cvt_pk_bf16(S1[2], S1[3]); *(u32x4*)(Sp + (size_t)c * 65536) = w; }
        }
        float* o = out + OFF_RSP + (size_t)bh * 65536 + (size_t)d8 * 256 + e;
        o[0] = S0[0]; o[256] = S0[1]; o[512] = S0[2]; o[768] = S0[3]; o[1024] = S1[0]; o[1280] = S1[1]; o[1536] = S1[2]; o[1792] = S1[3];
    }
}

__device__ __forceinline__ void retC_item(unsigned char* lds, const bf16_t* Z, const bf16_t* Sb, bf16_t* MIX, int item, int tid) {
    asm volatile("" : "+v"(tid));
    const int bh = item < 256 ? (item >> 4) : (item - 256), c = item < 256 ? 1 + (item & 15) : 0, b = bh >> 2, h = bh & 3;
    const int C = c == 0 ? 16 : 128, tok0 = c == 0 ? 0 : 16 + 128 * (c - 1);
    const size_t row0 = c == 0 ? (size_t)METAROW + b * 16 : (size_t)b * 2048 + 128 * (c - 1);
    const int wave = __builtin_amdgcn_readfirstlane(tid >> 6), lane = tid & 63, fr = lane & 15, fq = lane >> 4;
    bf16_t* Qs = (bf16_t*)lds; bf16_t* Ks = (bf16_t*)(lds + 67584); bf16_t* Vt = Ks;
    const float lg = lg2gamma(h);
    {
        u32x4 vq[8], vk[8];
#pragma unroll
        for (int i = 0; i < 8; ++i) {
            const int q = tid + 512 * i, r = q >> 5, ch = q & 31;
            vq[i] = (u32x4){0u, 0u, 0u, 0u}; vk[i] = vq[i];
            if (r < C) { const bf16_t* p = Z + (row0 + r) * PW + h * 256 + 8 * ch; vq[i] = *(const u32x4*)(p + ZQ); vk[i] = *(const u32x4*)(p + ZK); }
        }
#pragma unroll
        for (int i = 0; i < 8; ++i) { const int q = tid + 512 * i, r = q >> 5, ch = q & 31; *(u32x4*)(Qs + r * 264 + 8 * ch) = vq[i]; *(u32x4*)(Ks + r * 264 + 8 * ch) = vk[i]; }
    }
    const bf16_t* S = Sb + ((size_t)(bh * 16 + (c > 0 ? c - 1 : 0))) * 65536;
    u32x4 vra[4], vrb[4], sr[8];
    {
        const int dim0 = 8 * (4 * wave + fq);
#pragma unroll
        for (int i = 0; i < 4; ++i) {
            const int j0 = 2 * (16 * i + fr);
            vra[i] = (u32x4){0u, 0u, 0u, 0u}; vrb[i] = vra[i];
            if (j0 < C) vra[i] = *(const u32x4*)(Z + (row0 + j0) * PW + ZV + h * 256 + dim0);
            if (j0 + 1 < C) vrb[i] = *(const u32x4*)(Z + (row0 + j0 + 1) * PW + ZV + h * 256 + dim0);
        }
        if (c > 0) {
            int t2 = tid; asm volatile("" : "+v"(t2));
#pragma unroll
            for (int i = 0; i < 8; ++i) { const int q = t2 + 512 * i, r = q >> 5, ch = q & 31; sr[i] = *(const u32x4*)(S + r * 256 + 8 * ch); }
        }
    }
    asm volatile("" ::: "memory");
    __syncthreads();
    const int i0 = 16 * wave; const bool act = i0 < C;
    bf16x8 qf[8];
#pragma unroll
    for (int ks = 0; ks < 8; ++ks) qf[ks] = *(const bf16x8*)(Qs + (i0 + fr) * 264 + 32 * ks + 8 * fq);
    bf16x8 pf[4];
#pragma unroll
    for (int ks2 = 0; ks2 < 4; ++ks2) {
        f32x4 sA = (f32x4){0.f, 0.f, 0.f, 0.f}, sB = sA;
        if (act && 2 * ks2 <= wave) {
#pragma unroll
            for (int ks = 0; ks < 8; ++ks) { const bf16x8 kf = *(const bf16x8*)(Ks + (32 * ks2 + fr) * 264 + 32 * ks + 8 * fq); sA = mfma16(kf, qf[ks], sA); }
        }
        if (act && 2 * ks2 + 1 <= wave) {
#pragma unroll
            for (int ks = 0; ks < 8; ++ks) { const bf16x8 kf = *(const bf16x8*)(Ks + (32 * ks2 + 16 + fr) * 264 + 32 * ks + 8 * fq); sB = mfma16(kf, qf[ks], sB); }
        }
        float pa[4], pb[4];
#pragma unroll
        for (int r = 0; r < 4; ++r) {
            const int dA = (i0 + fr) - (32 * ks2 + 4 * fq + r), dB = dA - 16;
            pa[r] = dA >= 0 ? sA[r] * fexp2((float)dA * lg) : 0.f;
            pb[r] = dB >= 0 ? sB[r] * fexp2((float)dB * lg) : 0.f;
        }
        u32x4 w; w.x = cvt_pk_bf16(pa[0], pa[1]); w.y = cvt_pk_bf16(pa[2], pa[3]); w.z = cvt_pk_bf16(pb[0], pb[1]); w.w = cvt_pk_bf16(pb[2], pb[3]);
        pf[ks2] = as_bf16x8(w);
    }
    __syncthreads();
    {
        const int dim0 = 8 * (4 * wave + fq);
#pragma unroll
        for (int i = 0; i < 4; ++i) {
            const int j0 = 2 * (16 * i + fr);
#pragma unroll
            for (int u = 0; u < 8; ++u) {
                const unsigned xa = vra[i][u >> 1], xb = vrb[i][u >> 1];
                const unsigned v_a = (u & 1) ? (xa >> 16) : (xa & 0xffffu), v_b = (u & 1) ? (xb >> 16) : (xb & 0xffffu);
                *(unsigned*)(Vt + (dim0 + u) * 136 + j0) = v_a | (v_b << 16);
            }
        }
        if (c > 0) {
            int t2 = tid; asm volatile("" : "+v"(t2));
#pragma unroll
            for (int i = 0; i < 8; ++i) { const int q = t2 + 512 * i, r = q >> 5, ch = q & 31; *(u32x4*)(Qs + r * 264 + 8 * ch) = sr[i]; }
#pragma unroll
            for (int i = 0; i < 8; ++i) { const int q = t2 + 512 * i, r = q >> 5, ch = q & 31; sr[i] = *(const u32x4*)(S + (128 + r) * 256 + 8 * ch); }
        }
    }
    asm volatile("" ::: "memory");
    __syncthreads();
    f32x4 acc[16];
#pragma unroll
    for (int et = 0; et < 16; ++et) acc[et] = (f32x4){0.f, 0.f, 0.f, 0.f};
    if (c > 0) {
        if (act) {
#pragma unroll
            for (int et = 0; et < 8; ++et)
            {
#pragma unroll
                for (int ks = 0; ks < 8; ++ks) { const bf16x8 sf = *(const bf16x8*)(Qs + (16 * et + fr) * 264 + 32 * ks + 8 * fq); acc[et] = mfma16(qf[ks], sf, acc[et]); }
                asm volatile("" ::: "memory");
            }
        }
        __syncthreads();
        {
            int t2 = tid; asm volatile("" : "+v"(t2));
#pragma unroll
            for (int i = 0; i < 8; ++i) { const int q = t2 + 512 * i, r = q >> 5, ch = q & 31; *(u32x4*)(Qs + r * 264 + 8 * ch) = sr[i]; }
        }
        __syncthreads();
        if (act) {
#pragma unroll
            for (int et = 8; et < 16; ++et)
            {
#pragma unroll
                for (int ks = 0; ks < 8; ++ks) { const bf16x8 sf = *(const bf16x8*)(Qs + (16 * (et - 8) + fr) * 264 + 32 * ks + 8 * fq); acc[et] = mfma16(qf[ks], sf, acc[et]); }
                asm volatile("" ::: "memory");
            }
#pragma unroll
            for (int r = 0; r < 4; ++r) { const float sc = fexp2((float)(i0 + 4 * fq + r + 1) * lg);
#pragma unroll
                for (int et = 0; et < 16; ++et) acc[et][r] *= sc; }
        }
    }
    if (act) {
#pragma unroll
        for (int et = 0; et < 16; ++et) {
#pragma unroll
            for (int ks2 = 0; ks2 < 4; ++ks2) if (2 * ks2 <= wave) {
                const u32x2 v0 = *(const u32x2*)(Vt + (16 * et + fr) * 136 + 32 * ks2 + 4 * fq), v1 = *(const u32x2*)(Vt + (16 * et + fr) * 136 + 32 * ks2 + 16 + 4 * fq);
                acc[et] = mfma16(pf[ks2], as_bf16x8((u32x4){v0.x, v0.y, v1.x, v1.y}), acc[et]);
            }
            if (et & 1) asm volatile("" ::: "memory");
        }
    }
    __syncthreads();
    if (act) {
        float* T = (float*)lds + wave * (16 * 260);
#pragma unroll
        for (int r = 0; r < 4; ++r) {
            float s = 0.f;
#pragma unroll
            for (int et = 0; et < 16; ++et) s += acc[et][r];
            s += __shfl_xor(s, 1); s += __shfl_xor(s, 2); s += __shfl_xor(s, 4); s += __shfl_xor(s, 8);
            const float mean = s * (1.f / 256.f); float q = 0.f;
#pragma unroll
            for (int et = 0; et < 16; ++et) { const float dl = acc[et][r] - mean; q += dl * dl; }
            q += __shfl_xor(q, 1); q += __shfl_xor(q, 2); q += __shfl_xor(q, 4); q += __shfl_xor(q, 8);
            const float rstd = 1.f / sqrtf(q * (1.f / 256.f) + LN_EPS);
#pragma unroll
            for (int et = 0; et < 16; ++et) T[(4 * fq + r) * 260 + 16 * et + fr] = (acc[et][r] - mean) * rstd;
        }
        asm volatile("s_waitcnt lgkmcnt(0)" ::: "memory");
        int l2 = lane; asm volatile("" : "+v"(l2));
        u32x4 gt8[8];
#pragma unroll
        for (int k = 0; k < 8; ++k) { const int q = l2 + 64 * k, r = q >> 5, ch = q & 31, i = i0 + r; gt8[k] = (u32x4){0u, 0u, 0u, 0u}; if (i < C) gt8[k] = *(const u32x4*)(Z + (row0 + i) * PW + ZG + h * 256 + 8 * ch); }
#pragma unroll
        for (int k = 0; k < 8; ++k) {
            const int q = l2 + 64 * k, r = q >> 5, ch = q & 31, i = i0 + r;
            if (i < C) {
                const f32x4 x0 = *(const f32x4*)(T + r * 260 + 8 * ch), x1 = *(const f32x4*)(T + r * 260 + 8 * ch + 4);
                const u32x4 gg = gt8[k];
                u32x4 w;
                w.x = cvt_pk_bf16(x0[0] * bf2f(gg.x & 0xffffu), x0[1] * bf2f(gg.x >> 16)); w.y = cvt_pk_bf16(x0[2] * bf2f(gg.y & 0xffffu), x0[3] * bf2f(gg.y >> 16));
                w.z = cvt_pk_bf16(x1[0] * bf2f(gg.z & 0xffffu), x1[1] * bf2f(gg.z >> 16)); w.w = cvt_pk_bf16(x1[2] * bf2f(gg.w & 0xffffu), x1[3] * bf2f(gg.w >> 16));
                *(u32x4*)(MIX + (row0 + i) * D + h * 256 + 8 * ch) = w;
            }
        }
    }
    __syncthreads();
}

template <bool SAMPLE>
__device__ __forceinline__ void swa_item(unsigned char* lds, const bf16_t* Z, const float* ck, const float* cv, const float* sinks, bf16_t* MIX, int item, int tid) {
    asm volatile("" : "+v"(tid));
    const int wave = __builtin_amdgcn_readfirstlane(tid >> 6), lane = tid & 63, fr = lane & 15, fq = lane >> 4;
    bf16_t* Kb = (bf16_t*)lds; bf16_t* Vt = (bf16_t*)(lds + 39168);
    int b, blk = 0, g, nkeys, nit, kmin, tbase = 0;
    if (SAMPLE) { b = item >> 1; g = item & 1; nkeys = 136; nit = 1; kmin = 0; }
    else { b = item / 34; const int rem = item - b * 34; blk = rem >> 1; g = rem & 1; nkeys = 256; nit = blk == 16 ? 1 : 8; kmin = blk == 0 ? 128 : 0; tbase = blk * 128 - 128; }
#define SWA_RAW(kk_, ch_, zoff_, cache_, r0_, r1_) do { r0_ = (f32x4){0.f, 0.f, 0.f, 0.f}; r1_ = r0_; \
        if (SAMPLE) { if ((kk_) < 128) { const float* p_ = (cache_) + ((size_t)(b * 128 + (kk_)) * 2 + g) * 64 + 8 * (ch_); r0_ = *(const f32x4*)p_; r1_ = *(const f32x4*)(p_ + 4); } \
                      else if ((kk_) < 136) r0_ = *(const f32x4*)(Z + (size_t)(SROW + b * 8 + (kk_) - 128) * PW + (zoff_) + g * 64 + 8 * (ch_)); } \
        else { const int tp_ = tbase + (kk_); if ((kk_) < 256 && tp_ >= 0 && tp_ < LP) r0_ = *(const f32x4*)(Z + (size_t)prow(b, tp_) * PW + (zoff_) + g * 64 + 8 * (ch_)); } } while (0)
#define SWA_CVT(kk_, r0_, r1_, out_) do { union { f32x4 f; u32x4 u; } x_; x_.f = r0_; out_ = x_.u; \
        if (SAMPLE && (kk_) < 128) { out_.x = cvt_pk_bf16(r0_[0], r0_[1]); out_.y = cvt_pk_bf16(r0_[2], r0_[3]); out_.z = cvt_pk_bf16(r1_[0], r1_[1]); out_.w = cvt_pk_bf16(r1_[2], r1_[3]); } } while (0)
    {
        f32x4 k0[5], k1[5], va0[3], va1[3], vb0[3], vb1[3];
#pragma unroll
        for (int i = 0; i < 5; ++i) { const int q = tid + 512 * i, kk = q >> 3, ch = q & 7; k0[i] = (f32x4){0.f, 0.f, 0.f, 0.f}; k1[i] = k0[i]; if (q < 272 * 8) SWA_RAW(kk, ch, ZSK, ck, k0[i], k1[i]); }
#pragma unroll
        for (int i = 0; i < 3; ++i) { const int q = tid + 512 * i, ch = q / 140, pr = q - ch * 140; va0[i] = (f32x4){0.f, 0.f, 0.f, 0.f}; va1[i] = va0[i]; vb0[i] = va0[i]; vb1[i] = va0[i];
            if (q < 140 * 8) { SWA_RAW(2 * pr, ch, ZSV, cv, va0[i], va1[i]); SWA_RAW(2 * pr + 1, ch, ZSV, cv, vb0[i], vb1[i]); } }
#pragma unroll
        for (int i = 0; i < 5; ++i) { const int q = tid + 512 * i, kk = q >> 3, ch = q & 7; if (q < 272 * 8) { u32x4 v; SWA_CVT(kk, k0[i], k1[i], v); *(u32x4*)(Kb + kk * 72 + 8 * ch) = v; } }
#pragma unroll
        for (int i = 0; i < 3; ++i) {
            const int q = tid + 512 * i, ch = q / 140, pr = q - ch * 140;
            if (q < 140 * 8) {
                u32x4 va, vb; SWA_CVT(2 * pr, va0[i], va1[i], va); SWA_CVT(2 * pr + 1, vb0[i], vb1[i], vb);
#pragma unroll
                for (int u = 0; u < 8; ++u) {
                    const unsigned xa = va[u >> 1], xb = vb[u >> 1];
                    const unsigned v_a = (u & 1) ? (xa >> 16) : (xa & 0xffffu), v_b = (u & 1) ? (xb >> 16) : (xb & 0xffffu);
                    *(unsigned*)(Vt + (8 * ch + u) * 280 + 2 * pr) = v_a | (v_b << 16);
                }
            }
        }
    }
#undef SWA_RAW
#undef SWA_CVT
    __syncthreads();
    const int hq = g * 8 + wave; const float sink = sinks[hq];
#define SWA_LOADQ(it_, d0, d1) do { const int iq_ = 16 * (it_) + fr; bool qv_; size_t rowq_; \
        if (SAMPLE) { qv_ = fr < 8; rowq_ = (size_t)SROW + b * 8 + (fr & 7); } else { const int tq_ = blk * 128 + iq_; qv_ = tq_ < LP; rowq_ = (size_t)prow(b, qv_ ? tq_ : 0); } \
        d0 = (u32x4){0u, 0u, 0u, 0u}; d1 = d0; \
        if (qv_) { const bf16_t* p_ = Z + rowq_ * PW + ZSQ + hq * 64 + 8 * fq; d0 = *(const u32x4*)p_; d1 = *(const u32x4*)(p_ + 32); } } while (0)
    u32x4 q0n, q1n; SWA_LOADQ(0, q0n, q1n);
#pragma unroll 1
    for (int it = 0; it < nit; ++it) {
        const int i0 = 16 * it, iq = i0 + fr;
        const bf16x8 q0 = as_bf16x8(q0n), q1 = as_bf16x8(q1n);
        if (it + 1 < nit) SWA_LOADQ(it + 1, q0n, q1n);
        f32x4 s[10];
#pragma unroll
        for (int jj = 0; jj < 10; ++jj) {
            const bf16_t* kp = Kb + (16 * (it + jj) + fr) * 72 + 8 * fq;
            s[jj] = mfma16(*(const bf16x8*)kp, q0, (f32x4){0.f, 0.f, 0.f, 0.f});
            s[jj] = mfma16(*(const bf16x8*)(kp + 32), q1, s[jj]);
        }
        float mx = sink;
#pragma unroll
        for (int jj = 0; jj < 10; ++jj)
#pragma unroll
            for (int r = 0; r < 4; ++r) {
                const int kk = 16 * (it + jj) + 4 * fq + r;
                const bool ok = (kk > iq) && (kk <= iq + 128) && (kk >= kmin) && (kk < nkeys);
                s[jj][r] = ok ? s[jj][r] : -1e30f; mx = fmaxf(mx, s[jj][r]);
            }
        mx = fmaxf(mx, __shfl_xor(mx, 16)); mx = fmaxf(mx, __shfl_xor(mx, 32));
        float sum = 0.f;
#pragma unroll
        for (int jj = 0; jj < 10; ++jj)
#pragma unroll
            for (int r = 0; r < 4; ++r) { s[jj][r] = fexp(s[jj][r] - mx); sum += s[jj][r]; }
        sum += __shfl_xor(sum, 16); sum += __shfl_xor(sum, 32);
        const float inv = 1.f / (sum + fexp(sink - mx));
        bf16x8 pf[5];
#pragma unroll
        for (int k2 = 0; k2 < 5; ++k2) {
            u32x4 w; w.x = cvt_pk_bf16(s[2 * k2][0] * inv, s[2 * k2][1] * inv); w.y = cvt_pk_bf16(s[2 * k2][2] * inv, s[2 * k2][3] * inv);
            w.z = cvt_pk_bf16(s[2 * k2 + 1][0] * inv, s[2 * k2 + 1][1] * inv); w.w = cvt_pk_bf16(s[2 * k2 + 1][2] * inv, s[2 * k2 + 1][3] * inv);
            pf[k2] = as_bf16x8(w);
        }
        f32x4 o[4];
#pragma unroll
        for (int dt = 0; dt < 4; ++dt) {
            o[dt] = (f32x4){0.f, 0.f, 0.f, 0.f};
#pragma unroll
            for (int k2 = 0; k2 < 5; ++k2) {
                const bf16_t* vp = Vt + (16 * dt + fr) * 280 + 16 * (it + 2 * k2) + 4 * fq;
                const u32x2 v0 = *(const u32x2*)vp, v1 = *(const u32x2*)(vp + 16);
                o[dt] = mfma16(pf[k2], as_bf16x8((u32x4){v0.x, v0.y, v1.x, v1.y}), o[dt]);
            }
        }
#pragma unroll
        for (int r = 0; r < 4; ++r) {
            const int i = i0 + 4 * fq + r; bool ok; size_t row;
            if (SAMPLE) { ok = i < 8; row = (size_t)SROW + b * 8 + i; } else { const int tq = blk * 128 + i; ok = tq < LP; row = (size_t)prow(b, ok ? tq : 0); }
            if (ok) { bf16_t* mp = MIX + row * D + 1024 + hq * 64 + fr;
#pragma unroll
                for (int dt = 0; dt < 4; ++dt) mp[16 * dt] = f2bf(o[dt][r]); }
        }
    }
    __syncthreads();
}

#undef SWA_LOADQ
template <int MODE>
__device__ __forceinline__ void retS_item(unsigned char* lds, const bf16_t* Z, const float* state, float* out, bf16_t* MIX, bf16_t* SKV, int item, int tid) {
    asm volatile("" : "+v"(tid));
    const int b = item >> 2, h = item & 3; const size_t row0 = (size_t)SROW + b * 8;
    const int wave = __builtin_amdgcn_readfirstlane(tid >> 6), lane = tid & 63;
    float* qT = (float*)lds; float* kT = qT + 2048; float* vS = kT + 2048; float* sc = vS + 2048; float* cp = sc + 64;
    const float lg = lg2gamma(h);
    {
        const int t = tid >> 6, d4 = (tid & 63) * 4;
        bf16_t* skv = SKV + (size_t)item * 4096 + t * 256 + d4;
        u32x2 rk, rv;
        if (MODE == 0) {
            const bf16_t* p = Z + (row0 + t) * PW + h * 256 + d4;
            const u32x2 rq = *(const u32x2*)(p + ZQ); rk = *(const u32x2*)(p + ZK); rv = *(const u32x2*)(p + ZV);
            *(u32x2*)skv = rk; *(u32x2*)(skv + 2048) = rv;
            qT[(d4 + 0) * 8 + t] = bf2f(rq.x & 0xffffu); qT[(d4 + 1) * 8 + t] = bf2f(rq.x >> 16); qT[(d4 + 2) * 8 + t] = bf2f(rq.y & 0xffffu); qT[(d4 + 3) * 8 + t] = bf2f(rq.y >> 16);
        } else { rk = *(const u32x2*)skv; rv = *(const u32x2*)(skv + 2048); }
        kT[(d4 + 0) * 8 + t] = bf2f(rk.x & 0xffffu); kT[(d4 + 1) * 8 + t] = bf2f(rk.x >> 16); kT[(d4 + 2) * 8 + t] = bf2f(rk.y & 0xffffu); kT[(d4 + 3) * 8 + t] = bf2f(rk.y >> 16);
        *(f32x4*)(vS + t * 256 + d4) = (f32x4){bf2f(rv.x & 0xffffu), bf2f(rv.x >> 16), bf2f(rv.y & 0xffffu), bf2f(rv.y >> 16)};
    }
    __syncthreads();
    if (MODE == 0) {
        const int i = tid >> 6, j = (tid >> 3) & 7, part = tid & 7; float s = 0.f;
#pragma unroll 8
        for (int dd = 0; dd < 32; ++dd) { const int d = part * 32 + dd; s += qT[d * 8 + i] * kT[d * 8 + j]; }
        s += __shfl_xor(s, 1); s += __shfl_xor(s, 2); s += __shfl_xor(s, 4);
        if (part == 0) sc[i * 8 + j] = j <= i ? s * fexp2((float)(i - j) * lg) : 0.f;
    }
    const float* S = state + (size_t)(b * 4 + h) * 65536; float* SO = out + OFF_RSS + (size_t)(b * 4 + h) * 65536;
    const int e4 = lane * 4;
    u32x2 gg = (u32x2){0u, 0u};
    if (MODE == 0) gg = *(const u32x2*)(Z + (row0 + wave) * PW + ZG + h * 256 + e4);
    f32x4 vv[8], cr[8];
#pragma unroll
    for (int j = 0; j < 8; ++j) { vv[j] = *(const f32x4*)(vS + j * 256 + e4) * fexp2((float)(7 - j) * lg); cr[j] = (f32x4){0.f, 0.f, 0.f, 0.f}; }
    const float g8 = fexp2(8.f * lg);
#define RETS_LOAD(buf, db) _Pragma("unroll") for (int u = 0; u < 8; ++u) buf[u] = __builtin_nontemporal_load((const f32x4*)(S + (size_t)(32 * wave + (db) + u) * 256 + e4))
#define RETS_COMP(buf, db) _Pragma("unroll") for (int u = 0; u < 8; ++u) { \
        const int d = 32 * wave + (db) + u; \
        if (MODE == 0) { \
            const f32x4 qa = *(const f32x4*)(qT + d * 8), qb = *(const f32x4*)(qT + d * 8 + 4); \
            cr[0] += buf[u] * qa[0]; cr[1] += buf[u] * qa[1]; cr[2] += buf[u] * qa[2]; cr[3] += buf[u] * qa[3]; \
            cr[4] += buf[u] * qb[0]; cr[5] += buf[u] * qb[1]; cr[6] += buf[u] * qb[2]; cr[7] += buf[u] * qb[3]; \
        } else { \
            const f32x4 ka = *(const f32x4*)(kT + d * 8), kb = *(const f32x4*)(kT + d * 8 + 4); \
            f32x4 sn = buf[u] * g8; \
            sn += vv[0] * ka[0]; sn += vv[1] * ka[1]; sn += vv[2] * ka[2]; sn += vv[3] * ka[3]; \
            sn += vv[4] * kb[0]; sn += vv[5] * kb[1]; sn += vv[6] * kb[2]; sn += vv[7] * kb[3]; \
            __builtin_nontemporal_store(sn, (f32x4*)(SO + (size_t)d * 256 + e4)); } }
    {
        f32x4 sa[8], sb[8];
        RETS_LOAD(sa, 0); RETS_LOAD(sb, 8);
        RETS_COMP(sa, 0); RETS_LOAD(sa, 16);
        RETS_COMP(sb, 8); RETS_LOAD(sb, 24);
        RETS_COMP(sa, 16); RETS_COMP(sb, 24);
    }
#undef RETS_LOAD
#undef RETS_COMP
    if (MODE == 0) {
#pragma unroll
        for (int i = 0; i < 8; ++i) *(f32x4*)(cp + (wave * 8 + i) * 256 + e4) = cr[i];
        __syncthreads();
        const int i = wave; f32x4 o = (f32x4){0.f, 0.f, 0.f, 0.f};
#pragma unroll
        for (int w8 = 0; w8 < 8; ++w8) o += *(const f32x4*)(cp + (w8 * 8 + i) * 256 + e4);
        o *= fexp2((float)(i + 1) * lg);
#pragma unroll
        for (int j = 0; j < 8; ++j) o += *(const f32x4*)(vS + j * 256 + e4) * sc[i * 8 + j];
        const float mean = wave_sum((o[0] + o[1]) + (o[2] + o[3])) * (1.f / 256.f);
        const f32x4 dl = o - mean;
        const float var = wave_sum((dl[0] * dl[0] + dl[1] * dl[1]) + (dl[2] * dl[2] + dl[3] * dl[3])) * (1.f / 256.f);
        const float rstd = 1.f / sqrtf(var + LN_EPS);
        u32x2 w; w.x = cvt_pk_bf16(dl[0] * rstd * bf2f(gg.x & 0xffffu), dl[1] * rstd * bf2f(gg.x >> 16)); w.y = cvt_pk_bf16(dl[2] * rstd * bf2f(gg.y & 0xffffu), dl[3] * rstd * bf2f(gg.y >> 16));
        *(u32x2*)(MIX + (row0 + i) * D + h * 256 + e4) = w;
    }
    __syncthreads();
}

constexpr int NPHASE = 10;
__global__ void __launch_bounds__(512) fwd(Args a_unused) {
    extern __shared__ __attribute__((aligned(16))) unsigned char lds[];
    int lo, hi; { KArgs a = kargs(); lo = a->ph_lo; hi = a->ph_hi; }
    if (hi - lo > 1) {
        if (threadIdx.x == 0) { ((volatile LAS unsigned*)(lds + LDS_CTL))[0] = 0u; ((volatile LAS unsigned*)(lds + LDS_CTL))[1] = 0u; }
        __syncthreads();
        if (threadIdx.x == 0) { KArgs a = kargs(); (void)xb_add((unsigned*)(a->ws + WS_BAR) + XB_XCNT(xb_xcc_id()), 1u); }
    }
#define IN(k) (lo <= (k) && (k) < hi)
#define SEAM(k) do { if (IN(k) && IN((k) + 1)) { for (int _r = 0; _r < REPSYNC; ++_r) { KArgs _a = kargs(); xcd_barrier((unsigned*)(_a->ws + WS_BAR), (volatile LAS unsigned*)(lds + LDS_CTL)); } } } while (0)
#define WSP(T, off) ((T)(a->ws + (off)))
    if (IN(0)) { for (int _r = 0; _r < REP0; ++_r) { KArgs a = kargs(); phase0(a, lds, ltid(), gridDim.x); __syncthreads(); } }
    SEAM(0);
    if (IN(1)) {
        KArgs a = kargs(); const int G = gridDim.x;
        pg8::Gemm g{WSP(const bf16_t*, WS_H), WSP(const bf16_t*, WS_WIN), D, D, PW / 256, 0}; pg8::StaticOrder S; S.init(MR, PW, G, (int)blockIdx.x, 9);
        const float* cosR = WSP(const float*, WS_TAB);
        EpiIn E{WSP(bf16_t*, WS_Z), cosR, cosR + NPOS * 128, cosR + 2 * NPOS * 128, cosR + 2 * NPOS * 128 + NPOS * 8, a->out};
        for (int _r = 0; _r < 1 + ((REPG >> 0) & 1); ++_r) pg8::gemm_phase<EpiIn>((LAS unsigned char*)lds, g, S, E);
    }
    SEAM(1);
    for (int _rm = 0; _rm < REPMIX; ++_rm) {
    if (_rm > 0) { KArgs _a = kargs(); xcd_barrier((unsigned*)(_a->ws + WS_BAR), (volatile LAS unsigned*)(lds + LDS_CTL)); }
    if (IN(2)) {
        KArgs a = kargs(); const int G = gridDim.x, tid = ltid();
        bf16_t* Z = WSP(bf16_t*, WS_Z); bf16_t* MIX = WSP(bf16_t*, WS_MIX);
        unsigned* head = (unsigned*)(a->ws + WS_BAR) + 16;
        volatile LAS unsigned* qw = (volatile LAS unsigned*)(lds + LDS_CTL) + 2;
        for (;;) {
            if (tid == 0) *qw = __hip_atomic_fetch_add(head, 1u, __ATOMIC_RELAXED, __HIP_MEMORY_SCOPE_AGENT);
            __syncthreads();
            const int q = (int)*qw;
            if (q >= 136 + 512 + 272 + 256) break;
            if (q < 136) swa_item<false>(lds, Z, nullptr, nullptr, a->in[10], MIX, q, tid);
            else if (q < 648) retS_item<0>(lds, Z, a->in[2], a->out, MIX, WSP(bf16_t*, WS_SKV), q - 136, tid);
            else if (q < 920) retA_item(lds, Z, WSP(bf16_t*, WS_U), q - 648, tid);
            else swa_item<true>(lds, Z, a->in[3], a->in[4], a->in[10], MIX, q - 920, tid);
        }
    }
    SEAM(2);
    if (IN(3)) { KArgs a = kargs(); ret_scan(WSP(const bf16_t*, WS_U), WSP(bf16_t*, WS_SB), a->out, ltid(), gridDim.x); }
    SEAM(3);
    if (IN(4)) { KArgs a = kargs(); const int G = gridDim.x, tid = ltid(); for (int it = blockIdx.x; it < 256; it += G) retC_item(lds, WSP(const bf16_t*, WS_Z), WSP(const bf16_t*, WS_SB), WSP(bf16_t*, WS_MIX), it, tid); }
    }
    SEAM(4);
    if (IN(5)) {
        KArgs a = kargs(); const int G = gridDim.x;
        pg8::Gemm g{WSP(const bf16_t*, WS_MIX), WSP(const bf16_t*, WS_WO), D, D / 2, D / 256, (size_t)(D / 2) * 2}; pg8::StaticOrder S; S.init(MR, 2 * D, G, (int)blockIdx.x);
        EpiRes E{WSP(bf16_t*, WS_PRE), WSP(const bf16_t*, WS_H), WSP(bf16_t*, WS_Z)};
        for (int _r = 0; _r < 1 + ((REPG >> 1) & 1); ++_r) pg8::gemm_phase<EpiRes>((LAS unsigned char*)lds, g, S, E);
        const int nun = (MR / 256) * (2 * D / 256), rounds = (nun + G - 1) / G, first_idle = nun - (rounds - 1) * G;
        if (first_idle < G) { if ((int)blockIdx.x >= first_idle) { const int tid = ltid(); late_transposes(a, lds, tid, ((int)blockIdx.x - first_idle) * 8 + (tid >> 6), (G - first_idle) * 8); } }
        else { const int tid = ltid(); late_transposes(a, lds, tid, (int)blockIdx.x * 8 + (tid >> 6), G * 8); }
    }
    SEAM(5);
    if (IN(6)) {
        KArgs a = kargs(); const int G = gridDim.x, tid = ltid(), lane = tid & 63, wave = tid >> 6;
        for (int _r = 0; _r < REPLN; ++_r) for (int row = blockIdx.x * 8 + wave; row < MR; row += 2 * G * 8) {
            const int rowb = row + G * 8; const bool hasB = rowb < MR; const int rb = hasB ? rowb : row;
            ln2_bf16<false>(WSP(const bf16_t*, WS_PRE) + (size_t)row * D, WSP(const bf16_t*, WS_Z) + (size_t)row * D, WSP(const bf16_t*, WS_PRE) + (size_t)rb * D, WSP(const bf16_t*, WS_Z) + (size_t)rb * D, hasB,
                            a->in[11], a->in[12], WSP(bf16_t*, WS_H) + (size_t)row * D, WSP(bf16_t*, WS_H) + (size_t)rb * D, lane);
        }
    }
    SEAM(6);
    if (IN(7)) {
        KArgs a = kargs(); const int G = gridDim.x, c = (int)blockIdx.x;
        const pg8::Gemm gu{WSP(const bf16_t*, WS_H), WSP(const bf16_t*, WS_WGU), D, D, 2 * FF / 256, 0};
        const pg8::Gemm gd{WSP(const bf16_t*, WS_A2), WSP(const bf16_t*, WS_WD), FF, FF / 2, D / 256, (size_t)(FF / 2) * 2};
        const EpiGlu Eu{WSP(bf16_t*, WS_A2)};
        const EpiRes Ed{WSP(bf16_t*, WS_PRE), WSP(const bf16_t*, WS_H), WSP(bf16_t*, WS_PRE2)};
        constexpr int NP = MR / 256;
        pg8::StaticOrder S; S.init(MR - 512, 2 * FF, G, c); S.tailM = 2;
        const int nup = S.total(), nfull = nup / G, ntail = nup - nfull * G;
        int np1 = (G - ntail) / 16; if (np1 > NP - 2) np1 = NP - 2;
        const bool cut = ntail > 0 && ntail % 8 == 0 && (G - ntail) == np1 * 16 && G % 8 == 0 && (nfull * G - S.nwg) >= 0 && (hi - lo > 1);
        S.ilim = cut ? nfull : (1 << 20);
        pg8::gemm_phase<EpiGlu>((LAS unsigned char*)lds, gu, S, Eu);
        if (hi - lo > 1) { KArgs _a = kargs(); xcd_barrier((unsigned*)(_a->ws + WS_BAR), (volatile LAS unsigned*)(lds + LDS_CTL)); }
        if (cut) {
            if (c < ntail) {
                S.i0 = nfull; S.ilim = 1 << 20; pg8::gemm_phase<EpiGlu>((LAS unsigned char*)lds, gu, S, Eu);
                const int tid = ltid();
                unsigned* head = (unsigned*)(a->ws + WS_BAR) + 32;
                volatile LAS unsigned* qw = (volatile LAS unsigned*)(lds + LDS_CTL) + 2;
                if (tid == 0) *qw = __hip_atomic_fetch_add(head, 1u, __ATOMIC_RELAXED, __HIP_MEMORY_SCOPE_AGENT);
                __syncthreads();
                const int q = (int)*qw;
                if (q < 512) retS_item<1>(lds, nullptr, a->in[2], a->out, nullptr, WSP(bf16_t*, WS_SKV), q, tid);
            }
            else { pg8::StaticOrder T; T.init(np1 * 256, 2 * D, G - ntail, c - ntail); pg8::gemm_phase<EpiRes>((LAS unsigned char*)lds, gd, T, Ed); }
            { KArgs _a = kargs(); xcd_barrier((unsigned*)(_a->ws + WS_BAR), (volatile LAS unsigned*)(lds + LDS_CTL)); }
        }
        {
            const int p0 = cut ? np1 : 0;
            pg8::StaticOrder T; T.init((NP - p0) * 256, 2 * D, G, c); T.pm0 = p0;
            pg8::gemm_phase<EpiRes>((LAS unsigned char*)lds, gd, T, Ed);
        }
        {
            const int tid = ltid();
            unsigned* head = (unsigned*)(a->ws + WS_BAR) + 32;
            volatile LAS unsigned* qw = (volatile LAS unsigned*)(lds + LDS_CTL) + 2;
            for (;;) {
                if (tid == 0) *qw = __hip_atomic_fetch_add(head, 1u, __ATOMIC_RELAXED, __HIP_MEMORY_SCOPE_AGENT);
                __syncthreads();
                const int q = (int)*qw;
                if (q >= 512) break;
                retS_item<1>(lds, nullptr, a->in[2], a->out, nullptr, WSP(bf16_t*, WS_SKV), q, tid);
            }
        }
    }
    SEAM(8);
    if (IN(9)) {
        KArgs a = kargs(); const int G = gridDim.x, tid = ltid(), lane = tid & 63, wave = tid >> 6;
        for (int _r = 0; _r < REPLN; ++_r) for (int row = blockIdx.x * 8 + wave; row < MR; row += 2 * G * 8) {
            const int rowb = row + G * 8; const bool hasB = rowb < MR; const int rb = hasB ? rowb : row;
            float* da = row < SROW ? a->out + OFF_YP + (size_t)row * D : a->out + OFF_YS + (size_t)(row - SROW) * D;
            float* db = rb < SROW ? a->out + OFF_YP + (size_t)rb * D : a->out + OFF_YS + (size_t)(rb - SROW) * D;
            ln2_bf16<true>(WSP(const bf16_t*, WS_PRE) + (size_t)row * D, WSP(const bf16_t*, WS_PRE2) + (size_t)row * D, WSP(const bf16_t*, WS_PRE) + (size_t)rb * D, WSP(const bf16_t*, WS_PRE2) + (size_t)rb * D, hasB,
                           a->in[16], a->in[17], da, db, lane);
        }
    }
#undef IN
#undef SEAM
#undef WSP
}

extern "C" void kernel_launch(void* const* d_in, const int* in_sizes, int n_in, void* d_out, int out_size, void* d_ws, size_t ws_size, hipStream_t stream) {
    static int grid = 0;
    if (grid == 0) {
        if (n_in != 18 || ws_size < WS_END) { fprintf(stderr, "kernel_launch: unexpected n_in %d / ws_size %zu (need %zu)\n", n_in, ws_size, (size_t)WS_END); grid = -1; return; }
        int dev = 0, cus = 0, per_cu = 0;
        (void)hipGetDevice(&dev);
        (void)hipDeviceGetAttribute(&cus, hipDeviceAttributeMultiprocessorCount, dev);
        (void)hipFuncSetAttribute((const void*)fwd, hipFuncAttributeMaxDynamicSharedMemorySize, LDS_BYTES);
        (void)hipOccupancyMaxActiveBlocksPerMultiprocessor(&per_cu, (const void*)fwd, 512, LDS_BYTES);
        if (per_cu < 1) { fprintf(stderr, "kernel_launch: occupancy query reports %d blocks per CU\n", per_cu); per_cu = 1; }
        grid = cus * 1;
        (void)hipGetLastError();
    }
    if (grid < 0) return;
    Args a{};
    for (int i = 0; i < 18; ++i) a.in[i] = (const float*)d_in[i];
    a.out = (float*)d_out; a.ws = (unsigned char*)d_ws;
#if N_LAUNCH_MODE == 0
    (void)hipMemsetAsync((char*)d_ws + WS_BAR, 0, 3456 * 4, stream);
    a.ph_lo = 0; a.ph_hi = NPHASE;
    void* args[] = {&a};
    hipError_t e = hipLaunchCooperativeKernel((const void*)fwd, dim3(grid), dim3(512), args, LDS_BYTES, stream);
    if (e != hipSuccess) fprintf(stderr, "cooperative launch failed: %s (grid %d)\n", hipGetErrorString(e), grid);
#else
    for (int p = 0; p < NPHASE; ++p) {
        a.ph_lo = p; a.ph_hi = p + 1;
        void* args[] = {&a};
        hipError_t e = hipLaunchCooperativeKernel((const void*)fwd, dim3(grid), dim3(512), args, LDS_BYTES, stream);
        if (e != hipSuccess) fprintf(stderr, "launch %d failed: %s (grid %d)\n", p, hipGetErrorString(e), grid);
    }
#endif
}
```

```cpp
#include <hip/hip_runtime.h>
#include <hip/hip_cooperative_groups.h>
#include <cstdio>
namespace cg = cooperative_groups;

#ifndef N_LAUNCH_MODE
#define N_LAUNCH_MODE 0
#endif

#ifndef REP0
#define REP0 1
#endif
#ifndef REPMIX
#define REPMIX 1
#endif
#ifndef REPLN
#define REPLN 1
#endif
#ifndef REPG
#define REPG 0
#endif
#ifndef REPSYNC
#define REPSYNC 1
#endif
#define LAS __attribute__((address_space(3)))
typedef unsigned short bf16_t;
typedef short bf16x8 __attribute__((ext_vector_type(8)));
typedef float f32x4 __attribute__((ext_vector_type(4)));
typedef unsigned u32x4 __attribute__((ext_vector_type(4)));
typedef unsigned u32x2 __attribute__((ext_vector_type(2)));

constexpr int D = 2048, LP = 2064, MS = 1024, M = 9280, MPAD = 9472, PW = 5376, FF = 5632;
constexpr int SROW = 8192, MR = 9216, METAROW = 9216;
constexpr int ZQ = 0, ZK = 1024, ZV = 2048, ZG = 3072, ZSQ = 4096, ZSK = 5120, ZSV = 5248;
constexpr int NPOS = 2072;
constexpr float ALPHA = 1.189207115002721f, LN_EPS = 1e-5f;
constexpr size_t OFF_YP = 0, OFF_YS = 16777216, OFF_RSP = 18874368, OFF_KP = 19922944, OFF_VP = 19988480,
                 OFF_RSS = 20054016, OFF_KS = 53608448, OFF_VS = 55705600;
constexpr size_t WS_WIN = 0;
constexpr size_t WS_WO = WS_WIN + (size_t)PW * D * 2;
constexpr size_t WS_WGU = WS_WO + (size_t)D * D * 2;
constexpr size_t WS_MIX = WS_WGU + (size_t)2 * FF * D * 2;
constexpr size_t WS_WD = WS_MIX + (size_t)MPAD * D * 2;
constexpr size_t WS_H = WS_WD + (size_t)D * FF * 2;
constexpr size_t WS_PRE = WS_H + (size_t)MPAD * D * 2;
constexpr size_t WS_Z = WS_PRE + (size_t)MPAD * D * 4;
constexpr size_t WS_U = WS_Z + (size_t)MPAD * PW * 2;
constexpr size_t WS_SB = WS_U + (size_t)272 * 65536 * 4;
constexpr size_t WS_TAB = WS_SB + (size_t)256 * 65536 * 2;
constexpr size_t WS_BAR = WS_TAB + (((size_t)NPOS * 128 * 4 * 2 + (size_t)NPOS * 8 * 4 * 2 + 255) / 256) * 256;
constexpr size_t WS_SKV = WS_BAR + 16384;
constexpr size_t WS_END = WS_SKV + (size_t)512 * 2 * 8 * 256 * 2;
constexpr size_t WS_A2 = WS_Z;
constexpr size_t WS_PRE2 = WS_MIX;
static_assert((size_t)MPAD * D * 2 <= WS_WD - WS_MIX, "PRE2 alias");
static_assert((size_t)MPAD * FF * 2 <= WS_SB - WS_Z, "A2 alias");
constexpr int LDS_BYTES = 147456, LDS_CTL = 147440;

__device__ __forceinline__ float lg2gamma(int h) {
    return h == 0 ? -0.04580368961312479f : h == 1 ? -0.02272007650008353f : h == 2 ? -0.011315313227834146f : -0.005646563141142063f;
}
__device__ __forceinline__ int prow(int b, int t) { return t < 16 ? METAROW + b * 16 + t : b * 2048 + (t - 16); }
__device__ __forceinline__ float fexp2(float x) { return __builtin_amdgcn_exp2f(x); }
__device__ __forceinline__ float fexp(float x) { return __builtin_amdgcn_exp2f(x * 1.4426950408889634f); }
__device__ __forceinline__ float bf2f(unsigned b) { return __uint_as_float(b << 16); }
__device__ __forceinline__ unsigned cvt_pk_bf16(float lo, float hi) { unsigned r; asm volatile("v_cvt_pk_bf16_f32 %0, %1, %2" : "=v"(r) : "v"(lo), "v"(hi)); return r; }
__device__ __forceinline__ bf16_t f2bf(float f) { return (bf16_t)(cvt_pk_bf16(f, 0.f) & 0xffffu); }
__device__ __forceinline__ float silu(float x) { return x * __builtin_amdgcn_rcpf(1.f + fexp(-x)); }
__device__ __forceinline__ f32x4 ld4(const float* p, int i) { return ((const f32x4*)p)[i]; }
__device__ __forceinline__ f32x4 ld4(const bf16_t* p, int i) { const u32x2 r = ((const u32x2*)p)[i]; return (f32x4){bf2f(r.x & 0xffffu), bf2f(r.x >> 16), bf2f(r.y & 0xffffu), bf2f(r.y >> 16)}; }
__device__ __forceinline__ void unpack8(const u32x4 r, f32x4& lo, f32x4& hi) {
    lo = (f32x4){bf2f(r.x & 0xffffu), bf2f(r.x >> 16), bf2f(r.y & 0xffffu), bf2f(r.y >> 16)};
    hi = (f32x4){bf2f(r.z & 0xffffu), bf2f(r.z >> 16), bf2f(r.w & 0xffffu), bf2f(r.w >> 16)};
}
__device__ __forceinline__ float wave_sum(float v) {
#pragma unroll
    for (int o = 1; o < 64; o <<= 1) v += __shfl_xor(v, o);
    return v;
}
__device__ __forceinline__ f32x4 mfma16(bf16x8 a, bf16x8 b, f32x4 c) { return __builtin_amdgcn_mfma_f32_16x16x32_bf16(a, b, c, 0, 0, 0); }
__device__ __forceinline__ bf16x8 as_bf16x8(u32x4 v) { union { u32x4 u; bf16x8 b; } x; x.u = v; return x.b; }

struct Args { const float* in[18]; float* out; unsigned char* ws; int ph_lo, ph_hi; };
typedef const __attribute__((address_space(4))) Args* KArgs;
__device__ __forceinline__ KArgs kargs() { KArgs p = (KArgs)__builtin_amdgcn_kernarg_segment_ptr(); asm volatile("" : "+s"(p)); return p; }
__device__ __forceinline__ int ltid() { int t = threadIdx.x; asm volatile("" : "+v"(t)); return t; }


#define XB_TMO      128
#define XB_XCNT(j)  (256  + 64 * (j))
#define XB_XSUB(j)  (1280 + 64 * (j))
#define XB_XGEN(j)  (2304 + 64 * (j))
#define XB_TOP      3328
#define XB_TOPGEN   3392
#define XCD_BAR_WORDS 3456
#define XB_SPIN_CAP (1u << 18)
__device__ __forceinline__ unsigned xb_ld(unsigned* p)              { return __hip_atomic_load(p, __ATOMIC_RELAXED, __HIP_MEMORY_SCOPE_AGENT); }
__device__ __forceinline__ unsigned xb_add(unsigned* p, unsigned v) { return __hip_atomic_fetch_add(p, v, __ATOMIC_RELAXED, __HIP_MEMORY_SCOPE_AGENT); }
__device__ __forceinline__ unsigned xb_xcc_id() { return (unsigned)__builtin_amdgcn_s_getreg((3 << 11) | 20) & 0xFu; }
#define XB_SPIN(cond, bar) do { unsigned _sp = 0; while (cond) { __builtin_amdgcn_s_sleep(1); \
    if ((++_sp & 255u) == 0u) { if (xb_ld(&(bar)[XB_TMO])) break; if (_sp > XB_SPIN_CAP) { atomicAdd(&(bar)[XB_TMO], 1u); break; } } } } while (0)
__device__ __forceinline__ void xcd_barrier_complete(unsigned* bar, unsigned x, unsigned& nloc, unsigned& nx) {
    const unsigned G = gridDim.x * gridDim.y * gridDim.z;
    unsigned sum, cnt, mine, sp = 0u;
    for (;;) {
        sum = 0u; cnt = 0u; mine = 0u;
#pragma unroll
        for (unsigned j = 0; j < 16; ++j) { const unsigned c = xb_ld(&bar[XB_XCNT(j)]); sum += c; cnt += (c > 0u) ? 1u : 0u; mine = (j == x) ? c : mine; }
        if (sum == G) break;
        __builtin_amdgcn_s_sleep(1);
        if ((++sp & 255u) == 0u) { if (xb_ld(&bar[XB_TMO])) break; if (sp > XB_SPIN_CAP) { atomicAdd(&bar[XB_TMO], 1u); break; } }
    }
    nloc = mine > 0u ? mine : 1u; nx = cnt > 0u ? cnt : 1u;
}
__device__ __forceinline__ void xcd_barrier(unsigned* bar, volatile LAS unsigned* st) {
    asm volatile("s_waitcnt vmcnt(0)" ::: "memory");
    __syncthreads();
    if (threadIdx.x == 0) {
        const unsigned x = xb_xcc_id();
        __builtin_amdgcn_s_waitcnt(0);
        unsigned nloc = st[0], nx = st[1];
        if (nloc == 0u) { xcd_barrier_complete(bar, x, nloc, nx); st[0] = nloc; st[1] = nx; }
        const unsigned old = xb_add(&bar[XB_XSUB(x)], 1u);
        const unsigned gen = old / nloc;
        if (old + 1u == (gen + 1u) * nloc) {
            __builtin_amdgcn_fence(__ATOMIC_RELEASE, "agent");
            asm volatile("s_waitcnt vmcnt(0)" ::: "memory");
            const unsigned og = xb_add(&bar[XB_TOP], 1u);
            const unsigned tg = og / nx;
            if (og + 1u == (tg + 1u) * nx) xb_add(&bar[XB_TOPGEN], 1u);
            else XB_SPIN(xb_ld(&bar[XB_TOPGEN]) == tg, bar);
            __builtin_amdgcn_fence(__ATOMIC_ACQUIRE, "agent");
            xb_add(&bar[XB_XGEN(x)], 1u);
            asm volatile("s_waitcnt vmcnt(0)" ::: "memory");
        } else {
            XB_SPIN(xb_ld(&bar[XB_XGEN(x)]) == gen, bar);
            __builtin_amdgcn_fence(__ATOMIC_ACQUIRE, "agent");
            asm volatile("s_waitcnt vmcnt(0)" ::: "memory");
        }
    }
    __syncthreads();
}

namespace pg8 {
constexpr int BM = 256, BK = 64, HALF = 128, HTB = HALF * BK * 2, STAGE_BYTES = 8 * HTB, NXCD = 8, WGM = 4;
__device__ __forceinline__ int lds_byte(int r, int c) { const int st = (r >> 4) * 2 + (c >> 5), rr = r & 15, cc = c & 31, ob = rr * 64 + cc * 2; return st * 1024 + (ob ^ (((ob >> 9) & 1) << 5)); }
__device__ __forceinline__ void stage_rc(int b, int& R, int& C) { const int st = b / 1024, sb = b % 1024, swz = sb ^ (((sb >> 9) & 1) << 5); R = (st >> 1) * 16 + swz / 64; C = (st & 1) * 32 + (swz % 64) / 2; }
__device__ __forceinline__ int perm32(int rho) { const int n = rho >> 4, i = rho & 15; return 8 * (i >> 2) + 4 * n + (i & 3); }
struct Unit { int pm, pn; };
struct Gemm { const bf16_t* A; const bf16_t* Bt; int ld, K, nNr; size_t ksb; };
struct StaticOrder {
    int nM, nN, nwg, G, c, nextra;
    int i0, ilim;
    int tailM;
    int pm0;
    __device__ __forceinline__ void init(int M_, int N_, int G_, int c_, int nextra_ = 0) { nM = M_ / BM; nN = N_ / BM; nwg = nM * nN; G = G_; c = c_; nextra = nextra_; i0 = 0; ilim = 1 << 20; tailM = 0; pm0 = 0; }
    __device__ __forceinline__ int total() const { return nwg + nextra + tailM * nN; }
    __device__ __forceinline__ void tile(int wgid, int& pm, int& pn) const {
        { const int q = nwg / NXCD, r = nwg % NXCD, xcd = wgid % NXCD, off = wgid / NXCD; wgid = (xcd < r ? xcd * (q + 1) : r * (q + 1) + (xcd - r) * q) + off; }
        const int nig = WGM * nN, gid = wgid / nig, fm = gid * WGM, gsz = (nM - fm) < WGM ? (nM - fm) : WGM;
        pm = fm + ((wgid % nig) % gsz); pn = (wgid % nig) / gsz;
    }
    __device__ __forceinline__ bool next(int i, Unit& u) const {
        const int ii = i + i0; if (ii >= ilim) return false;
        const long L = (long)ii * G + c; if (L >= total()) return false;
        if (L >= nwg && tailM > 0) { const int x = (int)L - nwg; u.pm = pm0 + nM + x % tailM; u.pn = x / tailM; return true; }
        if (L >= nwg) { const int x = (int)L - nwg; u.pm = nM; u.pn = x < 8 ? 4 + x : 20; return true; }
        tile((int)L, u.pm, u.pn); u.pm += pm0; return true;
    }
};

template <class Epi>
__device__ __forceinline__ void gemm_phase(LAS unsigned char* lds, const Gemm g, const StaticOrder& S, const Epi& E) {
    const int tid = ltid(), wid = __builtin_amdgcn_readfirstlane(tid >> 6), lane = tid & 63, wr = wid >> 2, wc = wid & 3, fr = lane & 15, fq = lane >> 4;
    const int K = g.K, nt = K / BK;
    const int ld = g.ld;
    unsigned voffA[2], voffB[2];
#pragma unroll
    for (int i = 0; i < 2; ++i) { int R, C; stage_rc(tid * 16 + i * 8192, R, C); const int Rb = Epi::PERM ? ((R & ~31) + perm32(R & 31)) : R;
        voffA[i] = (unsigned)(R * ld + C) * 2u; voffB[i] = (unsigned)(Rb * ld + C) * 2u; }
    const size_t kstep = (size_t)(BK * 2);
    const size_t hstep = (size_t)HALF * ld * 2;
    const size_t tstep = 2 * hstep;
    const unsigned ldsw = (unsigned)wid * 1024u;
    const int aoff = lds_byte(wr * 64 + fr, fq * 8), boff = lds_byte(wc * 32 + fr, fq * 8);
#define PG8_SA(b, h) (((b) * 2 + (h)) * HTB)
#define PG8_SB(b, h) ((4 + (b) * 2 + (h)) * HTB)
#define PG8_STAGE(bufoff, gbase, voff) do { _Pragma("unroll") for (int _i = 0; _i < 2; ++_i) \
        __builtin_amdgcn_global_load_lds((const unsigned*)((const char*)(gbase) + (voff)[_i]), (LAS unsigned*)(lds + (bufoff) + ldsw + _i * 8192), 16, 0, 0); } while (0)
#define PG8_LDA(dst, b, h) do { _Pragma("unroll") for (int m = 0; m < 4; ++m) _Pragma("unroll") for (int k = 0; k < 2; ++k) dst[m][k] = *(const LAS bf16x8*)(lds + PG8_SA(b, h) + aoff + m * 2048 + k * 1024); } while (0)
#define PG8_LDB(dst, b, h) do { _Pragma("unroll") for (int n = 0; n < 2; ++n) _Pragma("unroll") for (int k = 0; k < 2; ++k) dst[n][k] = *(const LAS bf16x8*)(lds + PG8_SB(b, h) + boff + n * 2048 + k * 1024); } while (0)
#define PG8_MMA(ai, bj, At, Bt) do { __builtin_amdgcn_s_setprio(1); _Pragma("unroll") for (int m = 0; m < 4; ++m) _Pragma("unroll") for (int n = 0; n < 2; ++n) _Pragma("unroll") for (int k = 0; k < 2; ++k) \
        acc[ai][bj][m][n] = __builtin_amdgcn_mfma_f32_16x16x32_bf16(Bt[n][k], At[m][k], acc[ai][bj][m][n], 0, 0, 0); __builtin_amdgcn_s_setprio(0); } while (0)
#define PG8_WAIT_V(n) asm volatile("s_waitcnt vmcnt(" #n ")" ::: "memory")
#define PG8_WAIT_L(n) asm volatile("s_waitcnt lgkmcnt(" #n ")" ::: "memory")
#define PG8_BAR __builtin_amdgcn_s_barrier()
#define PG8_SCHED __builtin_amdgcn_sched_barrier(0)
    Unit cur, nxt; int ui = 0;
    if (!S.next(0, cur)) return;
    f32x4 acc[2][2][4][2];
#pragma unroll
    for (int a = 0; a < 2; ++a)
#pragma unroll
        for (int b = 0; b < 2; ++b)
#pragma unroll
            for (int m = 0; m < 4; ++m)
#pragma unroll
                for (int n = 0; n < 2; ++n) acc[a][b][m][n] = (f32x4){0.f, 0.f, 0.f, 0.f};
    bf16x8 At[4][2], B0[2][2], B1[2][2];
#define PG8_APTR(u) ((const char*)g.A + (size_t)(u).pm * tstep + (size_t)((u).pn / g.nNr) * g.ksb)
#define PG8_BPTR(u) ((const char*)g.Bt + (size_t)((u).pn % g.nNr) * tstep + (size_t)((u).pn / g.nNr) * g.ksb)
    const char* cA = PG8_APTR(cur); const char* cB = PG8_BPTR(cur);
    PG8_STAGE(PG8_SB(0, 0), cB, voffB); PG8_STAGE(PG8_SA(0, 0), cA, voffA); PG8_STAGE(PG8_SB(0, 1), cB + hstep, voffB); PG8_STAGE(PG8_SA(0, 1), cA + hstep, voffA);
    if (wr == 1) PG8_BAR;
    PG8_WAIT_V(4); PG8_BAR;
    PG8_STAGE(PG8_SB(1, 0), cB + kstep, voffB); PG8_STAGE(PG8_SA(1, 0), cA + kstep, voffA); PG8_STAGE(PG8_SB(1, 1), cB + hstep + kstep, voffB);
    PG8_WAIT_V(6); PG8_BAR;
    for (;;) {
        const bool has_next = S.next(ui + 1, nxt);
        const char* nA = has_next ? PG8_APTR(nxt) : cA; const char* nB = has_next ? PG8_BPTR(nxt) : cB;
        for (int t = 0; t < nt; t += 2) {
            const bool last = (t == nt - 2);
            const char* a1 = cA + (size_t)(t + 1) * kstep;
            const char* a2 = last ? nA : cA + (size_t)(t + 2) * kstep; const char* b2 = last ? nB : cB + (size_t)(t + 2) * kstep;
            const char* a3 = a2 + kstep; const char* b3 = b2 + kstep;
            PG8_LDB(B0, 0, 0); PG8_SCHED; PG8_LDA(At, 0, 0); PG8_STAGE(PG8_SA(1, 1), a1 + hstep, voffA);
            PG8_WAIT_L(8); PG8_BAR; PG8_WAIT_L(0); PG8_MMA(0, 0, At, B0); PG8_BAR; PG8_SCHED;
            PG8_LDB(B1, 0, 1); PG8_STAGE(PG8_SB(0, 0), b2, voffB);
            PG8_BAR; PG8_WAIT_L(0); PG8_MMA(0, 1, At, B1); PG8_BAR;
            PG8_LDA(At, 0, 1); PG8_STAGE(PG8_SA(0, 0), a2, voffA);
            PG8_BAR; PG8_WAIT_L(0); PG8_MMA(1, 0, At, B0); PG8_BAR; PG8_SCHED;
            PG8_STAGE(PG8_SB(0, 1), b2 + hstep, voffB);
            PG8_WAIT_V(6); PG8_BAR; PG8_MMA(1, 1, At, B1); PG8_BAR;
            PG8_LDB(B0, 1, 0); PG8_SCHED; PG8_LDA(At, 1, 0); PG8_STAGE(PG8_SA(0, 1), a2 + hstep, voffA);
            PG8_WAIT_L(8); PG8_BAR; PG8_WAIT_L(0); PG8_MMA(0, 0, At, B0); PG8_BAR; PG8_SCHED;
            PG8_LDB(B1, 1, 1); PG8_STAGE(PG8_SB(1, 0), b3, voffB);
            PG8_BAR; PG8_WAIT_L(0); PG8_MMA(0, 1, At, B1); PG8_BAR;
            PG8_LDA(At, 1, 1); PG8_STAGE(PG8_SA(1, 0), a3, voffA);
            PG8_BAR; PG8_WAIT_L(0); PG8_MMA(1, 0, At, B0); PG8_BAR; PG8_SCHED;
            PG8_STAGE(PG8_SB(1, 1), b3 + hstep, voffB);
            PG8_WAIT_V(6); PG8_BAR; PG8_MMA(1, 1, At, B1); PG8_BAR;
        }
        E(acc, cur, wr, wc, fr, fq);
        if (!has_next) break;
#pragma unroll
        for (int a = 0; a < 2; ++a)
#pragma unroll
            for (int b = 0; b < 2; ++b)
#pragma unroll
                for (int m = 0; m < 4; ++m)
#pragma unroll
                    for (int n = 0; n < 2; ++n) acc[a][b][m][n] = (f32x4){0.f, 0.f, 0.f, 0.f};
        cur = nxt; cA = nA; cB = nB; ++ui;
    }
    PG8_WAIT_V(0);
    if (wr == 0) PG8_BAR;
    PG8_BAR;
#undef PG8_APTR
#undef PG8_BPTR
#undef PG8_SA
#undef PG8_SB
#undef PG8_STAGE
#undef PG8_LDA
#undef PG8_LDB
#undef PG8_MMA
#undef PG8_WAIT_V
#undef PG8_WAIT_L
#undef PG8_BAR
#undef PG8_SCHED
}
}

struct EpiIn {
    static constexpr bool PERM = true;
    bf16_t* Z; const float* cosR; const float* sinR; const float* cosS; const float* sinS; float* out;
    __device__ __forceinline__ void operator()(const f32x4 (&acc)[2][2][4][2], const pg8::Unit& u, int wr, int wc, int fr, int fq) const {
        const int pn = u.pn;
#pragma unroll
        for (int ai = 0; ai < 2; ++ai) {
            f32x4 tc0[4], tc1[4], ts0[4], ts1[4];
            if (pn < 8 || pn >= 16) {
#pragma unroll
                for (int m = 0; m < 4; ++m) {
                    const int row = u.pm * 256 + ai * 128 + wr * 64 + m * 16 + fr; int tab = 0;
                    if (row < SROW) tab = 16 + (row & 2047); else if (row < MR) tab = LP + ((row - SROW) & 7); else if (row < M) tab = (row - METAROW) & 15;
                    const float* cp_ = pn < 8 ? cosR + tab * 128 + wc * 32 + 8 * fq : cosS + tab * 8;
                    const float* sp_ = pn < 8 ? sinR + tab * 128 + wc * 32 + 8 * fq : sinS + tab * 8;
                    tc0[m] = *(const f32x4*)cp_; tc1[m] = *(const f32x4*)(cp_ + 4); ts0[m] = *(const f32x4*)sp_; ts1[m] = *(const f32x4*)(sp_ + 4);
                }
            }
#pragma unroll
            for (int m = 0; m < 4; ++m) {
                const int row = u.pm * 256 + ai * 128 + wr * 64 + m * 16 + fr;
                int b = 0, t = 0, tab = 0; const bool isP = row < SROW || (row >= METAROW && row < M), isS = (row >= SROW) && (row < MR);
                if (row < SROW) { b = row >> 11; t = 16 + (row & 2047); tab = t; } else if (isS) { const int s = row - SROW; b = s >> 3; t = s & 7; tab = LP + t; }
                else if (isP) { const int mrow = row - METAROW; b = mrow >> 4; t = mrow & 15; tab = t; }
                f32x4 o00 = acc[ai][0][m][0], o01 = acc[ai][0][m][1], o10 = acc[ai][1][m][0], o11 = acc[ai][1][m][1];
                if (pn < 8) {
                    const f32x4 c0 = tc0[m], c1 = tc1[m], s0 = ts0[m], s1 = ts1[m];
                    const float sc = pn >= 4 ? 0.0625f : 1.0f;
                    const f32x4 a0 = o00, a1 = o01, b0 = o10, b1 = o11;
                    o00 = (a0 * c0 - b0 * s0) * sc; o10 = (b0 * c0 + a0 * s0) * sc;
                    o01 = (a1 * c1 - b1 * s1) * sc; o11 = (b1 * c1 + a1 * s1) * sc;
                } else if (pn < 12) {
                } else if (pn < 16) {
#pragma unroll
                    for (int j = 0; j < 4; ++j) { o00[j] = silu(o00[j]); o01[j] = silu(o01[j]); o10[j] = silu(o10[j]); o11[j] = silu(o11[j]); }
                } else {
                    const f32x4 c0 = tc0[m], c1 = tc1[m], s0 = ts0[m], s1 = ts1[m];
                    const bool rot = ((wc & 1) == 0) && (fq < 2); const float sg = fq == 0 ? -1.f : 1.f;
                    f32x4 p;
#pragma unroll
                    for (int j = 0; j < 4; ++j) p[j] = __shfl_xor(o00[j], 16);
                    if (rot) o00 = o00 * c0 + p * s0 * sg;
#pragma unroll
                    for (int j = 0; j < 4; ++j) p[j] = __shfl_xor(o01[j], 16);
                    if (rot) o01 = o01 * c1 + p * s1 * sg;
                    if (pn < 20) {
#pragma unroll
                        for (int j = 0; j < 4; ++j) p[j] = __shfl_xor(o10[j], 16);
                        if (rot) o10 = o10 * c0 + p * s0 * sg;
#pragma unroll
                        for (int j = 0; j < 4; ++j) p[j] = __shfl_xor(o11[j], 16);
                        if (rot) o11 = o11 * c1 + p * s1 * sg;
                        o00 *= 0.125f; o01 *= 0.125f; o10 *= 0.125f; o11 *= 0.125f;
                    } else {
                        const int cc = wc * 32 + 8 * fq;
                        if (isP && t >= LP - 128) {
                            float* kp = out + OFF_KP + ((size_t)(b * 128 + (t - (LP - 128))) * 128 + cc);
                            float* vp = out + OFF_VP + ((size_t)(b * 128 + (t - (LP - 128))) * 128 + cc);
                            *(f32x4*)kp = o00; *(f32x4*)(kp + 4) = o01; *(f32x4*)vp = o10; *(f32x4*)(vp + 4) = o11;
                        } else if (isS) {
                            float* kp = out + OFF_KS + ((size_t)(b * 128 + 120 + t) * 128 + cc);
                            float* vp = out + OFF_VS + ((size_t)(b * 128 + 120 + t) * 128 + cc);
                            *(f32x4*)kp = o00; *(f32x4*)(kp + 4) = o01; *(f32x4*)vp = o10; *(f32x4*)(vp + 4) = o11;
                        }
                    }
                }
                bf16_t* zrow = Z + (size_t)row * PW + pn * 256 + wc * 32 + 8 * fq;
                u32x4 w0, w1;
                w0.x = cvt_pk_bf16(o00[0], o00[1]); w0.y = cvt_pk_bf16(o00[2], o00[3]); w0.z = cvt_pk_bf16(o01[0], o01[1]); w0.w = cvt_pk_bf16(o01[2], o01[3]);
                w1.x = cvt_pk_bf16(o10[0], o10[1]); w1.y = cvt_pk_bf16(o10[2], o10[3]); w1.z = cvt_pk_bf16(o11[0], o11[1]); w1.w = cvt_pk_bf16(o11[2], o11[3]);
                *(u32x4*)zrow = w0; *(u32x4*)(zrow + 128) = w1;
            }
        }
    }
};
struct EpiRes {
    static constexpr bool PERM = true;
    bf16_t* PRE; const bf16_t* R; bf16_t* PRE2;
    __device__ __forceinline__ void operator()(const f32x4 (&acc)[2][2][4][2], const pg8::Unit& u, int wr, int wc, int fr, int fq) const {
        const bool second = u.pn >= 8; const int pn = u.pn & 7; bf16_t* dst = second ? PRE2 : PRE;
        u32x4 rr[2][4][2];
        if (!second) {
#pragma unroll
            for (int ai = 0; ai < 2; ++ai)
#pragma unroll
                for (int m = 0; m < 4; ++m)
#pragma unroll
                    for (int bj = 0; bj < 2; ++bj) rr[ai][m][bj] = *(const u32x4*)(R + (size_t)(u.pm * 256 + ai * 128 + wr * 64 + m * 16 + fr) * D + pn * 256 + wc * 32 + 8 * fq + bj * 128);
        }
#pragma unroll
        for (int ai = 0; ai < 2; ++ai)
#pragma unroll
            for (int m = 0; m < 4; ++m) {
                const size_t off = (size_t)(u.pm * 256 + ai * 128 + wr * 64 + m * 16 + fr) * D + pn * 256 + wc * 32 + 8 * fq;
#pragma unroll
                for (int bj = 0; bj < 2; ++bj) {
                    f32x4 o0 = acc[ai][bj][m][0], o1 = acc[ai][bj][m][1];
                    if (!second) {
                        const u32x4 r = rr[ai][m][bj];
                        o0 += (f32x4){bf2f(r.x & 0xffffu), bf2f(r.x >> 16), bf2f(r.y & 0xffffu), bf2f(r.y >> 16)} * ALPHA;
                        o1 += (f32x4){bf2f(r.z & 0xffffu), bf2f(r.z >> 16), bf2f(r.w & 0xffffu), bf2f(r.w >> 16)} * ALPHA;
                    }
                    u32x4 w; w.x = cvt_pk_bf16(o0[0], o0[1]); w.y = cvt_pk_bf16(o0[2], o0[3]); w.z = cvt_pk_bf16(o1[0], o1[1]); w.w = cvt_pk_bf16(o1[2], o1[3]);
                    *(u32x4*)(dst + off + bj * 128) = w;
                }
            }
    }
};
typedef float f32x2 __attribute__((ext_vector_type(2)));
__device__ __forceinline__ f32x2 glu_pk(f32x2 g, f32x2 u) {
    const f32x2 t = g * (-1.4426950408889634f);
    f32x2 e; e.x = __builtin_amdgcn_exp2f(t.x); e.y = __builtin_amdgcn_exp2f(t.y);
    const f32x2 d = e + 1.0f;
    f32x2 r; r.x = __builtin_amdgcn_rcpf(d.x); r.y = __builtin_amdgcn_rcpf(d.y);
    return (g * u) * r;
}
struct EpiGlu {
    static constexpr bool PERM = true;
    bf16_t* A2;
    __device__ __forceinline__ void operator()(const f32x4 (&acc)[2][2][4][2], const pg8::Unit& u, int wr, int wc, int fr, int fq) const {
#pragma unroll
        for (int ai = 0; ai < 2; ++ai)
#pragma unroll
            for (int m = 0; m < 4; ++m) {
                const size_t off = (size_t)(u.pm * 256 + ai * 128 + wr * 64 + m * 16 + fr) * FF + u.pn * 128 + wc * 32 + 8 * fq;
                const f32x4 g0 = acc[ai][0][m][0], g1 = acc[ai][0][m][1], u0 = acc[ai][1][m][0], u1 = acc[ai][1][m][1];
                const f32x2 a = glu_pk((f32x2){g0[0], g0[1]}, (f32x2){u0[0], u0[1]}), b = glu_pk((f32x2){g0[2], g0[3]}, (f32x2){u0[2], u0[3]});
                const f32x2 c = glu_pk((f32x2){g1[0], g1[1]}, (f32x2){u1[0], u1[1]}), d = glu_pk((f32x2){g1[2], g1[3]}, (f32x2){u1[2], u1[3]});
                u32x4 w; w.x = cvt_pk_bf16(a.x, a.y); w.y = cvt_pk_bf16(b.x, b.y); w.z = cvt_pk_bf16(c.x, c.y); w.w = cvt_pk_bf16(d.x, d.y);
                *(u32x4*)(A2 + off) = w;
            }
    }
};

__device__ __forceinline__ void transpose_item(const float* W, int K, int N, bf16_t* WT, int k0, int n0, int drow, float* scr, int lane) {
    f32x4 v[16];
#pragma unroll
    for (int i = 0; i < 16; ++i) { const int kk = 4 * i + (lane >> 4), c4 = lane & 15; v[i] = __builtin_nontemporal_load((const f32x4*)(W + (size_t)(k0 + kk) * N + n0 + 4 * c4)); }
#pragma unroll
    for (int i = 0; i < 16; ++i) {
        const int kk = 4 * i + (lane >> 4), c4 = lane & 15;
        float* s = scr + kk * 65 + 4 * c4; s[0] = v[i][0]; s[1] = v[i][1]; s[2] = v[i][2]; s[3] = v[i][3];
    }
    asm volatile("s_waitcnt lgkmcnt(0)" ::: "memory");
    const int c = lane & 7;
#pragma unroll
    for (int jn = 0; jn < 8; ++jn) {
        const int n = (lane >> 3) + 8 * jn; const float* s = scr + (8 * c) * 65 + n;
        u32x4 o; o.x = cvt_pk_bf16(s[0], s[65]); o.y = cvt_pk_bf16(s[130], s[195]); o.z = cvt_pk_bf16(s[260], s[325]); o.w = cvt_pk_bf16(s[390], s[455]);
        *(u32x4*)(WT + (size_t)(drow + n) * K + k0 + 8 * c) = o;
    }
    asm volatile("s_waitcnt lgkmcnt(0)" ::: "memory");
}
template <bool OUTF, bool TWO = false, class TI = float>
__device__ __forceinline__ void ln_row(const TI* xrow, const float* g, const float* bta, void* orow, int lane, const TI* xrow2 = nullptr) {
    f32x4 v[8]; float s = 0.f;
#pragma unroll
    for (int j = 0; j < 8; ++j) { v[j] = ld4(xrow, 64 * j + lane); if (TWO) v[j] += ld4(xrow2, 64 * j + lane); s += (v[j][0] + v[j][1]) + (v[j][2] + v[j][3]); }
    const float mean = wave_sum(s) * (1.f / D); float s2 = 0.f;
#pragma unroll
    for (int j = 0; j < 8; ++j) { v[j] = v[j] - mean; s2 += (v[j][0] * v[j][0] + v[j][1] * v[j][1]) + (v[j][2] * v[j][2] + v[j][3] * v[j][3]); }
    const float rstd = 1.f / sqrtf(wave_sum(s2) * (1.f / D) + LN_EPS);
#pragma unroll
    for (int j = 0; j < 8; ++j) {
        const f32x4 gg = ((const f32x4*)g)[64 * j + lane], bb = ((const f32x4*)bta)[64 * j + lane];
        const f32x4 y = v[j] * rstd * gg + bb;
        if (OUTF) ((f32x4*)orow)[64 * j + lane] = y;
        else { u32x2 w; w.x = cvt_pk_bf16(y[0], y[1]); w.y = cvt_pk_bf16(y[2], y[3]); ((u32x2*)orow)[64 * j + lane] = w; }
    }
}
template <bool OUTF>
__device__ __forceinline__ void ln2_bf16(const bf16_t* xa0, const bf16_t* xa1, const bf16_t* xb0, const bf16_t* xb1, bool hasB,
                                         const float* g, const float* bta, void* oa, void* ob, int lane) {
    u32x4 ra0[4], ra1[4], rb0[4], rb1[4]; f32x4 gg[8], bb[8];
#pragma unroll
    for (int j = 0; j < 4; ++j) { ra0[j] = ((const u32x4*)xa0)[64 * j + lane]; ra1[j] = ((const u32x4*)xa1)[64 * j + lane]; rb0[j] = ((const u32x4*)xb0)[64 * j + lane]; rb1[j] = ((const u32x4*)xb1)[64 * j + lane]; }
#pragma unroll
    for (int j = 0; j < 4; ++j) { gg[2 * j] = ((const f32x4*)g)[2 * (64 * j + lane)]; gg[2 * j + 1] = ((const f32x4*)g)[2 * (64 * j + lane) + 1];
                                  bb[2 * j] = ((const f32x4*)bta)[2 * (64 * j + lane)]; bb[2 * j + 1] = ((const f32x4*)bta)[2 * (64 * j + lane) + 1]; }
    f32x4 va[8], vb[8]; float sa = 0.f, sb = 0.f;
#pragma unroll
    for (int j = 0; j < 4; ++j) {
        f32x4 l0, h0, l1, h1;
        unpack8(ra0[j], l0, h0); unpack8(ra1[j], l1, h1); va[2 * j] = l0 + l1; va[2 * j + 1] = h0 + h1;
        unpack8(rb0[j], l0, h0); unpack8(rb1[j], l1, h1); vb[2 * j] = l0 + l1; vb[2 * j + 1] = h0 + h1;
    }
#pragma unroll
    for (int k = 0; k < 8; ++k) { sa += (va[k][0] + va[k][1]) + (va[k][2] + va[k][3]); sb += (vb[k][0] + vb[k][1]) + (vb[k][2] + vb[k][3]); }
    const float ma = wave_sum(sa) * (1.f / D), mb = wave_sum(sb) * (1.f / D); float qa = 0.f, qb = 0.f;
#pragma unroll
    for (int k = 0; k < 8; ++k) { va[k] = va[k] - ma; vb[k] = vb[k] - mb;
        qa += (va[k][0] * va[k][0] + va[k][1] * va[k][1]) + (va[k][2] * va[k][2] + va[k][3] * va[k][3]);
        qb += (vb[k][0] * vb[k][0] + vb[k][1] * vb[k][1]) + (vb[k][2] * vb[k][2] + vb[k][3] * vb[k][3]); }
    const float ra = 1.f / sqrtf(wave_sum(qa) * (1.f / D) + LN_EPS), rb = 1.f / sqrtf(wave_sum(qb) * (1.f / D) + LN_EPS);
#pragma unroll
    for (int j = 0; j < 4; ++j) {
        const f32x4 ya0 = va[2 * j] * ra * gg[2 * j] + bb[2 * j], ya1 = va[2 * j + 1] * ra * gg[2 * j + 1] + bb[2 * j + 1];
        const f32x4 yb0 = vb[2 * j] * rb * gg[2 * j] + bb[2 * j], yb1 = vb[2 * j + 1] * rb * gg[2 * j + 1] + bb[2 * j + 1];
        if (OUTF) {
            ((f32x4*)oa)[2 * (64 * j + lane)] = ya0; ((f32x4*)oa)[2 * (64 * j + lane) + 1] = ya1;
            if (hasB) { ((f32x4*)ob)[2 * (64 * j + lane)] = yb0; ((f32x4*)ob)[2 * (64 * j + lane) + 1] = yb1; }
        } else {
            u32x4 w; w.x = cvt_pk_bf16(ya0[0], ya0[1]); w.y = cvt_pk_bf16(ya0[2], ya0[3]); w.z = cvt_pk_bf16(ya1[0], ya1[1]); w.w = cvt_pk_bf16(ya1[2], ya1[3]);
            ((u32x4*)oa)[64 * j + lane] = w;
            if (hasB) { u32x4 x; x.x = cvt_pk_bf16(yb0[0], yb0[1]); x.y = cvt_pk_bf16(yb0[2], yb0[3]); x.z = cvt_pk_bf16(yb1[0], yb1[1]); x.w = cvt_pk_bf16(yb1[2], yb1[3]);
                ((u32x4*)ob)[64 * j + lane] = x; }
        }
    }
}
__device__ __forceinline__ void ln2_f32(const float* xa, const float* xb, bool hasB, const float* g, const float* bta, bf16_t* oa, bf16_t* ob, int lane) {
    f32x4 va[8], vb[8]; float sa = 0.f, sb = 0.f;
#pragma unroll
    for (int j = 0; j < 8; ++j) { va[j] = __builtin_nontemporal_load((const f32x4*)xa + 64 * j + lane); vb[j] = __builtin_nontemporal_load((const f32x4*)xb + 64 * j + lane); }
#pragma unroll
    for (int j = 0; j < 8; ++j) { sa += (va[j][0] + va[j][1]) + (va[j][2] + va[j][3]); sb += (vb[j][0] + vb[j][1]) + (vb[j][2] + vb[j][3]); }
    const float ma = wave_sum(sa) * (1.f / D), mb = wave_sum(sb) * (1.f / D); float qa = 0.f, qb = 0.f;
#pragma unroll
    for (int j = 0; j < 8; ++j) { va[j] = va[j] - ma; vb[j] = vb[j] - mb;
        qa += (va[j][0] * va[j][0] + va[j][1] * va[j][1]) + (va[j][2] * va[j][2] + va[j][3] * va[j][3]);
        qb += (vb[j][0] * vb[j][0] + vb[j][1] * vb[j][1]) + (vb[j][2] * vb[j][2] + vb[j][3] * vb[j][3]); }
    const float ra = 1.f / sqrtf(wave_sum(qa) * (1.f / D) + LN_EPS), rb = 1.f / sqrtf(wave_sum(qb) * (1.f / D) + LN_EPS);
#pragma unroll
    for (int j = 0; j < 8; ++j) {
        const f32x4 gg = ((const f32x4*)g)[64 * j + lane], bb = ((const f32x4*)bta)[64 * j + lane];
        const f32x4 ya = va[j] * ra * gg + bb, yb = vb[j] * rb * gg + bb;
        u32x2 w; w.x = cvt_pk_bf16(ya[0], ya[1]); w.y = cvt_pk_bf16(ya[2], ya[3]); ((u32x2*)oa)[64 * j + lane] = w;
        if (hasB) { u32x2 x; x.x = cvt_pk_bf16(yb[0], yb[1]); x.y = cvt_pk_bf16(yb[2], yb[3]); ((u32x2*)ob)[64 * j + lane] = x; }
    }
}
__device__ __forceinline__ void sincos_d(float ang, float& c, float& s) {
    const double a = (double)ang; const double k = rint(a * 0.63661977236758134308);
    double r = fma(-k, 1.5707963267948966192, a); r = fma(-k, 6.123233995736766e-17, r);
    const int q = ((int)k) & 3; const double r2 = r * r;
    const double sp = r * (1.0 + r2 * (-1.0 / 6.0 + r2 * (1.0 / 120.0 + r2 * (-1.0 / 5040.0 + r2 * (1.0 / 362880.0 + r2 * (-1.0 / 39916800.0 + r2 * (1.0 / 6227020800.0)))))));
    const double cp = 1.0 + r2 * (-0.5 + r2 * (1.0 / 24.0 + r2 * (-1.0 / 720.0 + r2 * (1.0 / 40320.0 + r2 * (-1.0 / 3628800.0 + r2 * (1.0 / 479001600.0 + r2 * (-1.0 / 87178291200.0)))))));
    const double ss = (q == 0) ? sp : (q == 1) ? cp : (q == 2) ? -sp : -cp;
    const double cc = (q == 0) ? cp : (q == 1) ? -sp : (q == 2) ? -cp : sp;
    c = (float)cc; s = (float)ss;
}
__device__ __forceinline__ double dpowi(double base, int n) { double r = 1.0, b = base; for (int i = 0; i < 8; ++i) { if (n & 1) r *= b; b *= b; n >>= 1; } return r; }

__device__ __forceinline__ void late_transposes(KArgs a, unsigned char* lds, int tid, int gw, int NGW) {
    const int wave = tid >> 6, lane = tid & 63;
    unsigned char* ws = a->ws;
    float* scr = (float*)(lds + wave * 16896);
    constexpr int I_G = 32 * 88, I_D = 88 * 32;
    for (int it = gw; it < 2 * I_G + I_D; it += NGW) {
        int r = it;
        if (r < I_G) { const int kb = r / 88, nb = r % 88; const int n0 = 64 * nb; transpose_item(a->in[13], D, FF, (bf16_t*)(ws + WS_WGU), 64 * kb, n0, 256 * (n0 >> 7) + (n0 & 127), scr, lane); continue; } r -= I_G;
        if (r < I_G) { const int kb = r / 88, nb = r % 88; const int n0 = 64 * nb; transpose_item(a->in[14], D, FF, (bf16_t*)(ws + WS_WGU), 64 * kb, n0, 256 * (n0 >> 7) + 128 + (n0 & 127), scr, lane); continue; } r -= I_G;
        { const int kb = r / 32, nb = r % 32; transpose_item(a->in[15], FF, D, (bf16_t*)(ws + WS_WD), 64 * kb, 64 * nb, 64 * nb, scr, lane); }
    }
}

__device__ __forceinline__ void phase0(KArgs a, unsigned char* lds, int tid, int G) {
    const int wave = tid >> 6, lane = tid & 63;
    const int gw = blockIdx.x * 8 + wave, NGW = G * 8;
    unsigned char* ws = a->ws;
    float* scr = (float*)(lds + wave * 16896);
    const int gt = blockIdx.x * 512 + tid, NGT = G * 512;
    for (int pass = 0; pass < 2; ++pass) {
    if ((pass == 0) == ((wave & 1) != 0)) {
    float* cosR = (float*)(ws + WS_TAB); float* sinR = cosR + NPOS * 128; float* cosS = sinR + NPOS * 128; float* sinS = cosS + NPOS * 8;
    for (int i = gt; i < NPOS * 128; i += NGT) {
        const int pi = i >> 7, f = i & 127; const int pos = pi < LP ? pi : 16384 + (pi - LP);
        const float inv = (float)dpowi(0.9300449458481392, f);
        float c, s; sincos_d((float)pos * inv, c, s); cosR[i] = c; sinR[i] = s;
    }
    for (int i = gt; i < NPOS * 8; i += NGT) {
        const int pi = i >> 3, f = i & 7; const int pos = pi < LP ? pi : 16384 + (pi - LP);
        const float inv = (float)dpowi(0.19392274474868576, f);
        float c, s; sincos_d((float)pos * inv, c, s); cosS[i] = c; sinS[i] = s;
    }
    } else {
    for (int it = gw; it < 32 * 84 + 32 * 32; it += NGW) {
        if (it < 32 * 84) { const int kb = it / 84, nb = it % 84; transpose_item(a->in[8], D, PW, (bf16_t*)(ws + WS_WIN), 64 * kb, 64 * nb, 64 * nb, scr, lane); }
        else { const int r = it - 32 * 84, kb = r / 32, nb = r % 32; transpose_item(a->in[9], D, D, (bf16_t*)(ws + WS_WO), 64 * kb, 64 * nb, 64 * nb, scr, lane); }
    }
    bf16_t* H = (bf16_t*)(ws + WS_H); bf16_t* MIX = (bf16_t*)(ws + WS_MIX);
    for (int row = M + gw; row < MPAD; row += NGW) {
        const u32x4 z = (u32x4){0u, 0u, 0u, 0u};
#pragma unroll
        for (int j = 0; j < 4; ++j) { ((u32x4*)(H + (size_t)row * D))[64 * j + lane] = z; ((u32x4*)(MIX + (size_t)row * D))[64 * j + lane] = z; }
    }
    for (int row = gw; row < M; row += 2 * NGW) {
        const int rowb = row + NGW; const bool hasB = rowb < M; const int rb = hasB ? rowb : row;
        const float* sa = row < SROW ? a->in[0] + (size_t)row * D : row < MR ? a->in[1] + (size_t)(row - SROW) * D : a->in[5] + (size_t)((row - METAROW) & 15) * D;
        const float* sb = rb < SROW ? a->in[0] + (size_t)rb * D : rb < MR ? a->in[1] + (size_t)(rb - SROW) * D : a->in[5] + (size_t)((rb - METAROW) & 15) * D;
        ln2_f32(sa, sb, hasB, a->in[6], a->in[7], H + (size_t)row * D, H + (size_t)rb * D, lane);
    }
    for (int i0 = gt; i0 < 128 * 120 * 32; i0 += 4 * NGT) {
        f32x4 kv[4], vv[4];
#pragma unroll
        for (int u = 0; u < 4; ++u) { const int i = i0 + u * NGT; if (i < 128 * 120 * 32) { const int b = i / (120 * 32), rem = i - b * (120 * 32); const size_t so = (size_t)b * 128 * 128 + 8 * 128 + (size_t)rem * 4;
            kv[u] = __builtin_nontemporal_load((const f32x4*)(a->in[3] + so)); vv[u] = __builtin_nontemporal_load((const f32x4*)(a->in[4] + so)); } }
#pragma unroll
        for (int u = 0; u < 4; ++u) { const int i = i0 + u * NGT; if (i < 128 * 120 * 32) { const int b = i / (120 * 32), rem = i - b * (120 * 32); const size_t dst = (size_t)b * 128 * 128 + (size_t)rem * 4;
            *(f32x4*)(a->out + OFF_KS + dst) = kv[u]; *(f32x4*)(a->out + OFF_VS + dst) = vv[u]; } }
    }
    }
    }
}

__device__ __forceinline__ void retA_item(unsigned char* lds, const bf16_t* Z, bf16_t* U, int item, int tid) {
    asm volatile("" : "+v"(tid));
    const int bh = item < 256 ? (item >> 4) : (item - 256), c = item < 256 ? 1 + (item & 15) : 0, b = bh >> 2, h = bh & 3;
    const int C = c == 0 ? 16 : 128, tok0 = c == 0 ? 0 : 16 + 128 * (c - 1);
    const size_t row0 = c == 0 ? (size_t)METAROW + b * 16 : (size_t)b * 2048 + 128 * (c - 1);
    const int wave = __builtin_amdgcn_readfirstlane(tid >> 6), lane = tid & 63, fr = lane & 15, fq = lane >> 4;
    bf16_t* Vt = (bf16_t*)lds; bf16_t* Kt = (bf16_t*)(lds + 69632);
    const float lg = lg2gamma(h);
    const int dim0 = 8 * (4 * wave + fq);
    {
        u32x4 ka[4], kb[4], va[4], vb[4];
#pragma unroll
        for (int i = 0; i < 4; ++i) {
            const int j0 = 2 * (16 * i + fr);
            ka[i] = (u32x4){0u, 0u, 0u, 0u}; kb[i] = ka[i]; va[i] = ka[i]; vb[i] = ka[i];
            if (j0 < C) { const bf16_t* p = Z + (row0 + j0) * PW + h * 256 + dim0; ka[i] = *(const u32x4*)(p + ZK); va[i] = *(const u32x4*)(p + ZV); }
            if (j0 + 1 < C) { const bf16_t* p = Z + (row0 + j0 + 1) * PW + h * 256 + dim0; kb[i] = *(const u32x4*)(p + ZK); vb[i] = *(const u32x4*)(p + ZV); }
        }
#pragma unroll
        for (int i = 0; i < 4; ++i) {
            const int j0 = 2 * (16 * i + fr);
            const float w0 = fexp2((float)(C - 1 - j0) * lg), w1 = fexp2((float)(C - 2 - j0) * lg);
#pragma unroll
            for (int u = 0; u < 8; ++u) {
                const unsigned wa = ka[i][u >> 1], wb = kb[i][u >> 1], xa = va[i][u >> 1], xb = vb[i][u >> 1];
                const unsigned k_a = (u & 1) ? (wa >> 16) : (wa & 0xffffu), k_b = (u & 1) ? (wb >> 16) : (wb & 0xffffu);
                const unsigned v_a = (u & 1) ? (xa >> 16) : (xa & 0xffffu), v_b = (u & 1) ? (xb >> 16) : (xb & 0xffffu);
                *(unsigned*)(Kt + (dim0 + u) * 136 + j0) = cvt_pk_bf16(bf2f(k_a) * w0, bf2f(k_b) * w1);
                *(unsigned*)(Vt + (dim0 + u) * 136 + j0) = v_a | (v_b << 16);
            }
        }
    }
    __syncthreads();
    const int nks = C == 16 ? 1 : 4;
    bf16_t* Uo = U + (size_t)(bh * 17 + c) * 65536;
#pragma unroll 1
    for (int pass = 0; pass < 2; ++pass) {
        f32x4 acc[2][8];
#pragma unroll
        for (int et = 0; et < 2; ++et)
#pragma unroll
            for (int dt = 0; dt < 8; ++dt) acc[et][dt] = (f32x4){0.f, 0.f, 0.f, 0.f};
#pragma unroll
        for (int ks = 0; ks < 4; ++ks) if (ks < nks) {
            const bf16x8 a0 = *(const bf16x8*)(Vt + (32 * wave + fr) * 136 + 32 * ks + 8 * fq);
            const bf16x8 a1 = *(const bf16x8*)(Vt + (32 * wave + 16 + fr) * 136 + 32 * ks + 8 * fq);
#pragma unroll
            for (int dt = 0; dt < 8; ++dt) {
                const bf16x8 bb = *(const bf16x8*)(Kt + (128 * pass + 16 * dt + fr) * 136 + 32 * ks + 8 * fq);
                acc[0][dt] = mfma16(bb, a0, acc[0][dt]); acc[1][dt] = mfma16(bb, a1, acc[1][dt]);
            }
        }
#pragma unroll
        for (int et = 0; et < 2; ++et)
#pragma unroll
            for (int dt = 0; dt < 8; ++dt)
            { u32x2 w; w.x = cvt_pk_bf16(acc[et][dt][0], acc[et][dt][1]); w.y = cvt_pk_bf16(acc[et][dt][2], acc[et][dt][3]);
              *(u32x2*)(Uo + (32 * wave + 16 * et + fr) * 256 + 128 * pass + 16 * dt + 4 * fq) = w; }
    }
    __syncthreads();
}

__device__ __forceinline__ void ret_scan(const bf16_t* U, bf16_t* Sb, float* out, int tid, int G) {
    for (int idx = blockIdx.x * 512 + tid; idx < 16 * 8192; idx += G * 512) {
        const int bh = idx >> 13, rem = idx & 8191, e = rem >> 5, d8 = (rem & 31) * 8, h = bh & 3;
        const float g128 = fexp2(128.f * lg2gamma(h));
        const bf16_t* Up = U + (size_t)bh * 17 * 65536 + e * 256 + d8;
        bf16_t* Sp = Sb + (size_t)bh * 16 * 65536 + e * 256 + d8;
        u32x4 ur[17];
#pragma unroll
        for (int c = 0; c < 17; ++c) ur[c] = *(const u32x4*)(Up + (size_t)c * 65536);
        f32x4 S0, S1; unpack8(ur[0], S0, S1);
#pragma unroll
        for (int c = 0; c < 17; ++c) {
            if (c > 0) { f32x4 u0, u1; unpack8(ur[c], u0, u1); S0 = S0 * g128 + u0; S1 = S1 * g128 + u1; }
            if (c < 16) { u32x4 w; w.x = cvt_pk_bf16(S0[0], S0[1]); w.y = cvt_pk_bf16(S0[2], S0[3]); w.z = cvt_pk_bf16(S1[0], S1[1]); w.w = cvt_pk_bf16(S1[2], S1[3]); *(u32x4*)(Sp + (size_t)c * 65536) = w; }
        }
        float* o = out + OFF_RSP + (size_t)bh * 65536 + (size_t)d8 * 256 + e;
        o[0] = S0[0]; o[256] = S0[1]; o[512] = S0[2]; o[768] = S0[3]; o[1024] = S1[0]; o[1280] = S1[1]; o[1536] = S1[2]; o[1792] = S1[3];
    }
}

__device__ __forceinline__ void retC_item(unsigned char* lds, const bf16_t* Z, const bf16_t* Sb, bf16_t* MIX, int item, int tid) {
    asm volatile("" : "+v"(tid));
    const int bh = item < 256 ? (item >> 4) : (item - 256), c = item < 256 ? 1 + (item & 15) : 0, b = bh >> 2, h = bh & 3;
    const int C = c == 0 ? 16 : 128, tok0 = c == 0 ? 0 : 16 + 128 * (c - 1);
    const size_t row0 = c == 0 ? (size_t)METAROW + b * 16 : (size_t)b * 2048 + 128 * (c - 1);
    const int wave = __builtin_amdgcn_readfirstlane(tid >> 6), lane = tid & 63, fr = lane & 15, fq = lane >> 4;
    bf16_t* Qs = (bf16_t*)lds; bf16_t* Ks = (bf16_t*)(lds + 67584); bf16_t* Vt = Ks;
    const float lg = lg2gamma(h);
    {
        u32x4 vq[8], vk[8];
#pragma unroll
        for (int i = 0; i < 8; ++i) {
            const int q = tid + 512 * i, r = q >> 5, ch = q & 31;
            vq[i] = (u32x4){0u, 0u, 0u, 0u}; vk[i] = vq[i];
            if (r < C) { const bf16_t* p = Z + (row0 + r) * PW + h * 256 + 8 * ch; vq[i] = *(const u32x4*)(p + ZQ); vk[i] = *(const u32x4*)(p + ZK); }
        }
#pragma unroll
        for (int i = 0; i < 8; ++i) { const int q = tid + 512 * i, r = q >> 5, ch = q & 31; *(u32x4*)(Qs + r * 264 + 8 * ch) = vq[i]; *(u32x4*)(Ks + r * 264 + 8 * ch) = vk[i]; }
    }
    const bf16_t* S = Sb + ((size_t)(bh * 16 + (c > 0 ? c - 1 : 0))) * 65536;
    u32x4 vra[4], vrb[4], sr[8];
    {
        const int dim0 = 8 * (4 * wave + fq);
#pragma unroll
        for (int i = 0; i < 4; ++i) {
            const int j0 = 2 * (16 * i + fr);
            vra[i] = (u32x4){0u, 0u, 0u, 0u}; vrb[i] = vra[i];
            if (j0 < C) vra[i] = *(const u32x4*)(Z + (row0 + j0) * PW + ZV + h * 256 + dim0);
            if (j0 + 1 < C) vrb[i] = *(const u32x4*)(Z + (row0 + j0 + 1) * PW + ZV + h * 256 + dim0);
        }
        if (c > 0) {
            int t2 = tid; asm volatile("" : "+v"(t2));
#pragma unroll
            for (int i = 0; i < 8; ++i) { const int q = t2 + 512 * i, r = q >> 5, ch = q & 31; sr[i] = *(const u32x4*)(S + r * 256 + 8 * ch); }
        }
    }
    asm volatile("" ::: "memory");
    __syncthreads();
    const int i0 = 16 * wave; const bool act = i0 < C;
    bf16x8 qf[8];
#pragma unroll
    for (int ks = 0; ks < 8; ++ks) qf[ks] = *(const bf16x8*)(Qs + (i0 + fr) * 264 + 32 * ks + 8 * fq);
    bf16x8 pf[4];
#pragma unroll
    for (int ks2 = 0; ks2 < 4; ++ks2) {
        f32x4 sA = (f32x4){0.f, 0.f, 0.f, 0.f}, sB = sA;
        if (act && 2 * ks2 <= wave) {
#pragma unroll
            for (int ks = 0; ks < 8; ++ks) { const bf16x8 kf = *(const bf16x8*)(Ks + (32 * ks2 + fr) * 264 + 32 * ks + 8 * fq); sA = mfma16(kf, qf[ks], sA); }
        }
        if (act && 2 * ks2 + 1 <= wave) {
#pragma unroll
            for (int ks = 0; ks < 8; ++ks) { const bf16x8 kf = *(const bf16x8*)(Ks + (32 * ks2 + 16 + fr) * 264 + 32 * ks + 8 * fq); sB = mfma16(kf, qf[ks], sB); }
        }
        float pa[4], pb[4];
#pragma unroll
        for (int r = 0; r < 4; ++r) {
            const int dA = (i0 + fr) - (32 * ks2 + 4 * fq + r), dB = dA - 16;
            pa[r] = dA >= 0 ? sA[r] * fexp2((float)dA * lg) : 0.f;
            pb[r] = dB >= 0 ? sB[r] * fexp2((float)dB * lg) : 0.f;
        }
        u32x4 w; w.x = cvt_pk_bf16(pa[0], pa[1]); w.y = cvt_pk_bf16(pa[2], pa[3]); w.z = cvt_pk_bf16(pb[0], pb[1]); w.w = cvt_pk_bf16(pb[2], pb[3]);
        pf[ks2] = as_bf16x8(w);
    }
    __syncthreads();
    {
        const int dim0 = 8 * (4 * wave + fq);
#pragma unroll
        for (int i = 0; i < 4; ++i) {
            const int j0 = 2 * (16 * i + fr);
#pragma unroll
            for (int u = 0; u < 8; ++u) {
                const unsigned xa = vra[i][u >> 1], xb = vrb[i][u >> 1];
                const unsigned v_a = (u & 1) ? (xa >> 16) : (xa & 0xffffu), v_b = (u & 1) ? (xb >> 16) : (xb & 0xffffu);
                *(unsigned*)(Vt + (dim0 + u) * 136 + j0) = v_a | (v_b << 16);
            }
        }
        if (c > 0) {
            int t2 = tid; asm volatile("" : "+v"(t2));
#pragma unroll
            for (int i = 0; i < 8; ++i) { const int q = t2 + 512 * i, r = q >> 5, ch = q & 31; *(u32x4*)(Qs + r * 264 + 8 * ch) = sr[i]; }
#pragma unroll
            for (int i = 0; i < 8; ++i) { const int q = t2 + 512 * i, r = q >> 5, ch = q & 31; sr[i] = *(const u32x4*)(S + (128 + r) * 256 + 8 * ch); }
        }
    }
    asm volatile("" ::: "memory");
    __syncthreads();
    f32x4 acc[16];
#pragma unroll
    for (int et = 0; et < 16; ++et) acc[et] = (f32x4){0.f, 0.f, 0.f, 0.f};
    if (c > 0) {
        if (act) {
#pragma unroll
            for (int et = 0; et < 8; ++et)
            {
#pragma unroll
                for (int ks = 0; ks < 8; ++ks) { const bf16x8 sf = *(const bf16x8*)(Qs + (16 * et + fr) * 264 + 32 * ks + 8 * fq); acc[et] = mfma16(qf[ks], sf, acc[et]); }
                asm volatile("" ::: "memory");
            }
        }
        __syncthreads();
        {
            int t2 = tid; asm volatile("" : "+v"(t2));
#pragma unroll
            for (int i = 0; i < 8; ++i) { const int q = t2 + 512 * i, r = q >> 5, ch = q & 31; *(u32x4*)(Qs + r * 264 + 8 * ch) = sr[i]; }
        }
        __syncthreads();
        if (act) {
#pragma unroll
            for (int et = 8; et < 16; ++et)
            {
#pragma unroll
                for (int ks = 0; ks < 8; ++ks) { const bf16x8 sf = *(const bf16x8*)(Qs + (16 * (et - 8) + fr) * 264 + 32 * ks + 8 * fq); acc[et] = mfma16(qf[ks], sf, acc[et]); }
                asm volatile("" ::: "memory");
            }
#pragma unroll
            for (int r = 0; r < 4; ++r) { const float sc = fexp2((float)(i0 + 4 * fq + r + 1) * lg);
#pragma unroll
                for (int et = 0; et < 16; ++et) acc[et][r] *= sc; }
        }
    }
    if (act) {
#pragma unroll
        for (int et = 0; et < 16; ++et) {
#pragma unroll
            for (int ks2 = 0; ks2 < 4; ++ks2) if (2 * ks2 <= wave) {
                const u32x2 v0 = *(const u32x2*)(Vt + (16 * et + fr) * 136 + 32 * ks2 + 4 * fq), v1 = *(const u32x2*)(Vt + (16 * et + fr) * 136 + 32 * ks2 + 16 + 4 * fq);
                acc[et] = mfma16(pf[ks2], as_bf16x8((u32x4){v0.x, v0.y, v1.x, v1.y}), acc[et]);
            }
            if (et & 1) asm volatile("" ::: "memory");
        }
    }
    __syncthreads();
    if (act) {
        float* T = (float*)lds + wave * (16 * 260);
#pragma unroll
        for (int r = 0; r < 4; ++r) {
            float s = 0.f;
#pragma unroll
            for (int et = 0; et < 16; ++et) s += acc[et][r];
            s += __shfl_xor(s, 1); s += __shfl_xor(s, 2); s += __shfl_xor(s, 4); s += __shfl_xor(s, 8);
            const float mean = s * (1.f / 256.f); float q = 0.f;
#pragma unroll
            for (int et = 0; et < 16; ++et) { const float dl = acc[et][r] - mean; q += dl * dl; }
            q += __shfl_xor(q, 1); q += __shfl_xor(q, 2); q += __shfl_xor(q, 4); q += __shfl_xor(q, 8);
            const float rstd = 1.f / sqrtf(q * (1.f / 256.f) + LN_EPS);
#pragma unroll
            for (int et = 0; et < 16; ++et) T[(4 * fq + r) * 260 + 16 * et + fr] = (acc[et][r] - mean) * rstd;
        }
        asm volatile("s_waitcnt lgkmcnt(0)" ::: "memory");
        int l2 = lane; asm volatile("" : "+v"(l2));
        u32x4 gt8[8];
#pragma unroll
        for (int k = 0; k < 8; ++k) { const int q = l2 + 64 * k, r = q >> 5, ch = q & 31, i = i0 + r; gt8[k] = (u32x4){0u, 0u, 0u, 0u}; if (i < C) gt8[k] = *(const u32x4*)(Z + (row0 + i) * PW + ZG + h * 256 + 8 * ch); }
#pragma unroll
        for (int k = 0; k < 8; ++k) {
            const int q = l2 + 64 * k, r = q >> 5, ch = q & 31, i = i0 + r;
            if (i < C) {
                const f32x4 x0 = *(const f32x4*)(T + r * 260 + 8 * ch), x1 = *(const f32x4*)(T + r * 260 + 8 * ch + 4);
                const u32x4 gg = gt8[k];
                u32x4 w;
                w.x = cvt_pk_bf16(x0[0] * bf2f(gg.x & 0xffffu), x0[1] * bf2f(gg.x >> 16)); w.y = cvt_pk_bf16(x0[2] * bf2f(gg.y & 0xffffu), x0[3] * bf2f(gg.y >> 16));
                w.z = cvt_pk_bf16(x1[0] * bf2f(gg.z & 0xffffu), x1[1] * bf2f(gg.z >> 16)); w.w = cvt_pk_bf16(x1[2] * bf2f(gg.w & 0xffffu), x1[3] * bf2f(gg.w >> 16));
                *(u32x4*)(MIX + (row0 + i) * D + h * 256 + 8 * ch) = w;
            }
        }
    }
    __syncthreads();
}

template <bool SAMPLE>
__device__ __forceinline__ void swa_item(unsigned char* lds, const bf16_t* Z, const float* ck, const float* cv, const float* sinks, bf16_t* MIX, int item, int tid) {
    asm volatile("" : "+v"(tid));
    const int wave = __builtin_amdgcn_readfirstlane(tid >> 6), lane = tid & 63, fr = lane & 15, fq = lane >> 4;
    bf16_t* Kb = (bf16_t*)lds; bf16_t* Vt = (bf16_t*)(lds + 39168);
    int b, blk = 0, g, nkeys, nit, kmin, tbase = 0;
    if (SAMPLE) { b = item >> 1; g = item & 1; nkeys = 136; nit = 1; kmin = 0; }
    else { b = item / 34; const int rem = item - b * 34; blk = rem >> 1; g = rem & 1; nkeys = 256; nit = blk == 16 ? 1 : 8; kmin = blk == 0 ? 128 : 0; tbase = blk * 128 - 128; }
#define SWA_RAW(kk_, ch_, zoff_, cache_, r0_, r1_) do { r0_ = (f32x4){0.f, 0.f, 0.f, 0.f}; r1_ = r0_; \
        if (SAMPLE) { if ((kk_) < 128) { const float* p_ = (cache_) + ((size_t)(b * 128 + (kk_)) * 2 + g) * 64 + 8 * (ch_); r0_ = *(const f32x4*)p_; r1_ = *(const f32x4*)(p_ + 4); } \
                      else if ((kk_) < 136) r0_ = *(const f32x4*)(Z + (size_t)(SROW + b * 8 + (kk_) - 128) * PW + (zoff_) + g * 64 + 8 * (ch_)); } \
        else { const int tp_ = tbase + (kk_); if ((kk_) < 256 && tp_ >= 0 && tp_ < LP) r0_ = *(const f32x4*)(Z + (size_t)prow(b, tp_) * PW + (zoff_) + g * 64 + 8 * (ch_)); } } while (0)
#define SWA_CVT(kk_, r0_, r1_, out_) do { union { f32x4 f; u32x4 u; } x_; x_.f = r0_; out_ = x_.u; \
        if (SAMPLE && (kk_) < 128) { out_.x = cvt_pk_bf16(r0_[0], r0_[1]); out_.y = cvt_pk_bf16(r0_[2], r0_[3]); out_.z = cvt_pk_bf16(r1_[0], r1_[1]); out_.w = cvt_pk_bf16(r1_[2], r1_[3]); } } while (0)
    {
        f32x4 k0[5], k1[5], va0[3], va1[3], vb0[3], vb1[3];
#pragma unroll
        for (int i = 0; i < 5; ++i) { const int q = tid + 512 * i, kk = q >> 3, ch = q & 7; k0[i] = (f32x4){0.f, 0.f, 0.f, 0.f}; k1[i] = k0[i]; if (q < 272 * 8) SWA_RAW(kk, ch, ZSK, ck, k0[i], k1[i]); }
#pragma unroll
        for (int i = 0; i < 3; ++i) { const int q = tid + 512 * i, ch = q / 140, pr = q - ch * 140; va0[i] = (f32x4){0.f, 0.f, 0.f, 0.f}; va1[i] = va0[i]; vb0[i] = va0[i]; vb1[i] = va0[i];
            if (q < 140 * 8) { SWA_RAW(2 * pr, ch, ZSV, cv, va0[i], va1[i]); SWA_RAW(2 * pr + 1, ch, ZSV, cv, vb0[i], vb1[i]); } }
#pragma unroll
        for (int i = 0; i < 5; ++i) { const int q = tid + 512 * i, kk = q >> 3, ch = q & 7; if (q < 272 * 8) { u32x4 v; SWA_CVT(kk, k0[i], k1[i], v); *(u32x4*)(Kb + kk * 72 + 8 * ch) = v; } }
#pragma unroll
        for (int i = 0; i < 3; ++i) {
            const int q = tid + 512 * i, ch = q / 140, pr = q - ch * 140;
            if (q < 140 * 8) {
                u32x4 va, vb; SWA_CVT(2 * pr, va0[i], va1[i], va); SWA_CVT(2 * pr + 1, vb0[i], vb1[i], vb);
#pragma unroll
                for (int u = 0; u < 8; ++u) {
                    const unsigned xa = va[u >> 1], xb = vb[u >> 1];
                    const unsigned v_a = (u & 1) ? (xa >> 16) : (xa & 0xffffu), v_b = (u & 1) ? (xb >> 16) : (xb & 0xffffu);
                    *(unsigned*)(Vt + (8 * ch + u) * 280 + 2 * pr) = v_a | (v_b << 16);
                }
            }
        }
    }
#undef SWA_RAW
#undef SWA_CVT
    __syncthreads();
    const int hq = g * 8 + wave; const float sink = sinks[hq];
#define SWA_LOADQ(it_, d0, d1) do { const int iq_ = 16 * (it_) + fr; bool qv_; size_t rowq_; \
        if (SAMPLE) { qv_ = fr < 8; rowq_ = (size_t)SROW + b * 8 + (fr & 7); } else { const int tq_ = blk * 128 + iq_; qv_ = tq_ < LP; rowq_ = (size_t)prow(b, qv_ ? tq_ : 0); } \
        d0 = (u32x4){0u, 0u, 0u, 0u}; d1 = d0; \
        if (qv_) { const bf16_t* p_ = Z + rowq_ * PW + ZSQ + hq * 64 + 8 * fq; d0 = *(const u32x4*)p_; d1 = *(const u32x4*)(p_ + 32); } } while (0)
    u32x4 q0n, q1n; SWA_LOADQ(0, q0n, q1n);
#pragma unroll 1
    for (int it = 0; it < nit; ++it) {
        const int i0 = 16 * it, iq = i0 + fr;
        const bf16x8 q0 = as_bf16x8(q0n), q1 = as_bf16x8(q1n);
        if (it + 1 < nit) SWA_LOADQ(it + 1, q0n, q1n);
        f32x4 s[10];
#pragma unroll
        for (int jj = 0; jj < 10; ++jj) {
            const bf16_t* kp = Kb + (16 * (it + jj) + fr) * 72 + 8 * fq;
            s[jj] = mfma16(*(const bf16x8*)kp, q0, (f32x4){0.f, 0.f, 0.f, 0.f});
            s[jj] = mfma16(*(const bf16x8*)(kp + 32), q1, s[jj]);
        }
        float mx = sink;
#pragma unroll
        for (int jj = 0; jj < 10; ++jj)
#pragma unroll
            for (int r = 0; r < 4; ++r) {
                const int kk = 16 * (it + jj) + 4 * fq + r;
                const bool ok = (kk > iq) && (kk <= iq + 128) && (kk >= kmin) && (kk < nkeys);
                s[jj][r] = ok ? s[jj][r] : -1e30f; mx = fmaxf(mx, s[jj][r]);
            }
        mx = fmaxf(mx, __shfl_xor(mx, 16)); mx = fmaxf(mx, __shfl_xor(mx, 32));
        float sum = 0.f;
#pragma unroll
        for (int jj = 0; jj < 10; ++jj)
#pragma unroll
            for (int r = 0; r < 4; ++r) { s[jj][r] = fexp(s[jj][r] - mx); sum += s[jj][r]; }
        sum += __shfl_xor(sum, 16); sum += __shfl_xor(sum, 32);
        const float inv = 1.f / (sum + fexp(sink - mx));
        bf16x8 pf[5];
#pragma unroll
        for (int k2 = 0; k2 < 5; ++k2) {
            u32x4 w; w.x = cvt_pk_bf16(s[2 * k2][0] * inv, s[2 * k2][1] * inv); w.y = cvt_pk_bf16(s[2 * k2][2] * inv, s[2 * k2][3] * inv);
            w.z = cvt_pk_bf16(s[2 * k2 + 1][0] * inv, s[2 * k2 + 1][1] * inv); w.w = cvt_pk_bf16(s[2 * k2 + 1][2] * inv, s[2 * k2 + 1][3] * inv);
            pf[k2] = as_bf16x8(w);
        }
        f32x4 o[4];
#pragma unroll
        for (int dt = 0; dt < 4; ++dt) {
            o[dt] = (f32x4){0.f, 0.f, 0.f, 0.f};
#pragma unroll
            for (int k2 = 0; k2 < 5; ++k2) {
                const bf16_t* vp = Vt + (16 * dt + fr) * 280 + 16 * (it + 2 * k2) + 4 * fq;
                const u32x2 v0 = *(const u32x2*)vp, v1 = *(const u32x2*)(vp + 16);
                o[dt] = mfma16(pf[k2], as_bf16x8((u32x4){v0.x, v0.y, v1.x, v1.y}), o[dt]);
            }
        }
#pragma unroll
        for (int r = 0; r < 4; ++r) {
            const int i = i0 + 4 * fq + r; bool ok; size_t row;
            if (SAMPLE) { ok = i < 8; row = (size_t)SROW + b * 8 + i; } else { const int tq = blk * 128 + i; ok = tq < LP; row = (size_t)prow(b, ok ? tq : 0); }
            if (ok) { bf16_t* mp = MIX + row * D + 1024 + hq * 64 + fr;
#pragma unroll
                for (int dt = 0; dt < 4; ++dt) mp[16 * dt] = f2bf(o[dt][r]); }
        }
    }
    __syncthreads();
}

#undef SWA_LOADQ
template <int MODE>
__device__ __forceinline__ void retS_item(unsigned char* lds, const bf16_t* Z, const float* state, float* out, bf16_t* MIX, bf16_t* SKV, int item, int tid) {
    asm volatile("" : "+v"(tid));
    const int b = item >> 2, h = item & 3; const size_t row0 = (size_t)SROW + b * 8;
    const int wave = __builtin_amdgcn_readfirstlane(tid >> 6), lane = tid & 63;
    float* qT = (float*)lds; float* kT = qT + 2048; float* vS = kT + 2048; float* sc = vS + 2048; float* cp = sc + 64;
    const float lg = lg2gamma(h);
    {
        const int t = tid >> 6, d4 = (tid & 63) * 4;
        bf16_t* skv = SKV + (size_t)item * 4096 + t * 256 + d4;
        u32x2 rk, rv;
        if (MODE == 0) {
            const bf16_t* p = Z + (row0 + t) * PW + h * 256 + d4;
            const u32x2 rq = *(const u32x2*)(p + ZQ); rk = *(const u32x2*)(p + ZK); rv = *(const u32x2*)(p + ZV);
            *(u32x2*)skv = rk; *(u32x2*)(skv + 2048) = rv;
            qT[(d4 + 0) * 8 + t] = bf2f(rq.x & 0xffffu); qT[(d4 + 1) * 8 + t] = bf2f(rq.x >> 16); qT[(d4 + 2) * 8 + t] = bf2f(rq.y & 0xffffu); qT[(d4 + 3) * 8 + t] = bf2f(rq.y >> 16);
        } else { rk = *(const u32x2*)skv; rv = *(const u32x2*)(skv + 2048); }
        kT[(d4 + 0) * 8 + t] = bf2f(rk.x & 0xffffu); kT[(d4 + 1) * 8 + t] = bf2f(rk.x >> 16); kT[(d4 + 2) * 8 + t] = bf2f(rk.y & 0xffffu); kT[(d4 + 3) * 8 + t] = bf2f(rk.y >> 16);
        *(f32x4*)(vS + t * 256 + d4) = (f32x4){bf2f(rv.x & 0xffffu), bf2f(rv.x >> 16), bf2f(rv.y & 0xffffu), bf2f(rv.y >> 16)};
    }
    __syncthreads();
    if (MODE == 0) {
        const int i = tid >> 6, j = (tid >> 3) & 7, part = tid & 7; float s = 0.f;
#pragma unroll 8
        for (int dd = 0; dd < 32; ++dd) { const int d = part * 32 + dd; s += qT[d * 8 + i] * kT[d * 8 + j]; }
        s += __shfl_xor(s, 1); s += __shfl_xor(s, 2); s += __shfl_xor(s, 4);
        if (part == 0) sc[i * 8 + j] = j <= i ? s * fexp2((float)(i - j) * lg) : 0.f;
    }
    const float* S = state + (size_t)(b * 4 + h) * 65536; float* SO = out + OFF_RSS + (size_t)(b * 4 + h) * 65536;
    const int e4 = lane * 4;
    u32x2 gg = (u32x2){0u, 0u};
    if (MODE == 0) gg = *(const u32x2*)(Z + (row0 + wave) * PW + ZG + h * 256 + e4);
    f32x4 vv[8], cr[8];
#pragma unroll
    for (int j = 0; j < 8; ++j) { vv[j] = *(const f32x4*)(vS + j * 256 + e4) * fexp2((float)(7 - j) * lg); cr[j] = (f32x4){0.f, 0.f, 0.f, 0.f}; }
    const float g8 = fexp2(8.f * lg);
#define RETS_LOAD(buf, db) _Pragma("unroll") for (int u = 0; u < 8; ++u) buf[u] = __builtin_nontemporal_load((const f32x4*)(S + (size_t)(32 * wave + (db) + u) * 256 + e4))
#define RETS_COMP(buf, db) _Pragma("unroll") for (int u = 0; u < 8; ++u) { \
        const int d = 32 * wave + (db) + u; \
        if (MODE == 0) { \
            const f32x4 qa = *(const f32x4*)(qT + d * 8), qb = *(const f32x4*)(qT + d * 8 + 4); \
            cr[0] += buf[u] * qa[0]; cr[1] += buf[u] * qa[1]; cr[2] += buf[u] * qa[2]; cr[3] += buf[u] * qa[3]; \
            cr[4] += buf[u] * qb[0]; cr[5] += buf[u] * qb[1]; cr[6] += buf[u] * qb[2]; cr[7] += buf[u] * qb[3]; \
        } else { \
            const f32x4 ka = *(const f32x4*)(kT + d * 8), kb = *(const f32x4*)(kT + d * 8 + 4); \
            f32x4 sn = buf[u] * g8; \
            sn += vv[0] * ka[0]; sn += vv[1] * ka[1]; sn += vv[2] * ka[2]; sn += vv[3] * ka[3]; \
            sn += vv[4] * kb[0]; sn += vv[5] * kb[1]; sn += vv[6] * kb[2]; sn += vv[7] * kb[3]; \
            __builtin_nontemporal_store(sn, (f32x4*)(SO + (size_t)d * 256 + e4)); } }
    {
        f32x4 sa[8], sb[8];
        RETS_LOAD(sa, 0); RETS_LOAD(sb, 8);
        RETS_COMP(sa, 0); RETS_LOAD(sa, 16);
        RETS_COMP(sb, 8); RETS_LOAD(sb, 24);
        RETS_COMP(sa, 16); RETS_COMP(sb, 24);
    }
#undef RETS_LOAD
#undef RETS_COMP
    if (MODE == 0) {
#pragma unroll
        for (int i = 0; i < 8; ++i) *(f32x4*)(cp + (wave * 8 + i) * 256 + e4) = cr[i];
        __syncthreads();
        const int i = wave; f32x4 o = (f32x4){0.f, 0.f, 0.f, 0.f};
#pragma unroll
        for (int w8 = 0; w8 < 8; ++w8) o += *(const f32x4*)(cp + (w8 * 8 + i) * 256 + e4);
        o *= fexp2((float)(i + 1) * lg);
#pragma unroll
        for (int j = 0; j < 8; ++j) o += *(const f32x4*)(vS + j * 256 + e4) * sc[i * 8 + j];
        const float mean = wave_sum((o[0] + o[1]) + (o[2] + o[3])) * (1.f / 256.f);
        const f32x4 dl = o - mean;
        const float var = wave_sum((dl[0] * dl[0] + dl[1] * dl[1]) + (dl[2] * dl[2] + dl[3] * dl[3])) * (1.f / 256.f);
        const float rstd = 1.f / sqrtf(var + LN_EPS);
        u32x2 w; w.x = cvt_pk_bf16(dl[0] * rstd * bf2f(gg.x & 0xffffu), dl[1] * rstd * bf2f(gg.x >> 16)); w.y = cvt_pk_bf16(dl[2] * rstd * bf2f(gg.y & 0xffffu), dl[3] * rstd * bf2f(gg.y >> 16));
        *(u32x2*)(MIX + (row0 + i) * D + h * 256 + e4) = w;
    }
    __syncthreads();
}

constexpr int NPHASE = 10;
__global__ void __launch_bounds__(512) fwd(Args a_unused) {
    extern __shared__ __attribute__((aligned(16))) unsigned char lds[];
    int lo, hi; { KArgs a = kargs(); lo = a->ph_lo; hi = a->ph_hi; }
    if (hi - lo > 1) {
        if (threadIdx.x == 0) { ((volatile LAS unsigned*)(lds + LDS_CTL))[0] = 0u; ((volatile LAS unsigned*)(lds + LDS_CTL))[1] = 0u; }
        __syncthreads();
        if (threadIdx.x == 0) { KArgs a = kargs(); (void)xb_add((unsigned*)(a->ws + WS_BAR) + XB_XCNT(xb_xcc_id()), 1u); }
    }
#define IN(k) (lo <= (k) && (k) < hi)
#define SEAM(k) do { if (IN(k) && IN((k) + 1)) { for (int _r = 0; _r < REPSYNC; ++_r) { KArgs _a = kargs(); xcd_barrier((unsigned*)(_a->ws + WS_BAR), (volatile LAS unsigned*)(lds + LDS_CTL)); } } } while (0)
#define WSP(T, off) ((T)(a->ws + (off)))
    if (IN(0)) { for (int _r = 0; _r < REP0; ++_r) { KArgs a = kargs(); phase0(a, lds, ltid(), gridDim.x); __syncthreads(); } }
    SEAM(0);
    if (IN(1)) {
        KArgs a = kargs(); const int G = gridDim.x;
        pg8::Gemm g{WSP(const bf16_t*, WS_H), WSP(const bf16_t*, WS_WIN), D, D, PW / 256, 0}; pg8::StaticOrder S; S.init(MR, PW, G, (int)blockIdx.x, 9);
        const float* cosR = WSP(const float*, WS_TAB);
        EpiIn E{WSP(bf16_t*, WS_Z), cosR, cosR + NPOS * 128, cosR + 2 * NPOS * 128, cosR + 2 * NPOS * 128 + NPOS * 8, a->out};
        for (int _r = 0; _r < 1 + ((REPG >> 0) & 1); ++_r) pg8::gemm_phase<EpiIn>((LAS unsigned char*)lds, g, S, E);
    }
    SEAM(1);
    for (int _rm = 0; _rm < REPMIX; ++_rm) {
    if (_rm > 0) { KArgs _a = kargs(); xcd_barrier((unsigned*)(_a->ws + WS_BAR), (volatile LAS unsigned*)(lds + LDS_CTL)); }
    if (IN(2)) {
        KArgs a = kargs(); const int G = gridDim.x, tid = ltid();
        bf16_t* Z = WSP(bf16_t*, WS_Z); bf16_t* MIX = WSP(bf16_t*, WS_MIX);
        unsigned* head = (unsigned*)(a->ws + WS_BAR) + 16;
        volatile LAS unsigned* qw = (volatile LAS unsigned*)(lds + LDS_CTL) + 2;
        for (;;) {
            if (tid == 0) *qw = __hip_atomic_fetch_add(head, 1u, __ATOMIC_RELAXED, __HIP_MEMORY_SCOPE_AGENT);
            __syncthreads();
            const int q = (int)*qw;
            if (q >= 136 + 512 + 272 + 256) break;
            if (q < 136) swa_item<false>(lds, Z, nullptr, nullptr, a->in[10], MIX, q, tid);
            else if (q < 648) retS_item<0>(lds, Z, a->in[2], a->out, MIX, WSP(bf16_t*, WS_SKV), q - 136, tid);
            else if (q < 920) retA_item(lds, Z, WSP(bf16_t*, WS_U), q - 648, tid);
            else swa_item<true>(lds, Z, a->in[3], a->in[4], a->in[10], MIX, q - 920, tid);
        }
    }
    SEAM(2);
    if (IN(3)) { KArgs a = kargs(); ret_scan(WSP(const bf16_t*, WS_U), WSP(bf16_t*, WS_SB), a->out, ltid(), gridDim.x); }
    SEAM(3);
    if (IN(4)) { KArgs a = kargs(); const int G = gridDim.x, tid = ltid(); for (int it = blockIdx.x; it < 256; it += G) retC_item(lds, WSP(const bf16_t*, WS_Z), WSP(const bf16_t*, WS_SB), WSP(bf16_t*, WS_MIX), it, tid); }
    }
    SEAM(4);
    if (IN(5)) {
        KArgs a = kargs(); const int G = gridDim.x;
        pg8::Gemm g{WSP(const bf16_t*, WS_MIX), WSP(const bf16_t*, WS_WO), D, D / 2, D / 256, (size_t)(D / 2) * 2}; pg8::StaticOrder S; S.init(MR, 2 * D, G, (int)blockIdx.x);
        EpiRes E{WSP(bf16_t*, WS_PRE), WSP(const bf16_t*, WS_H), WSP(bf16_t*, WS_Z)};
        for (int _r = 0; _r < 1 + ((REPG >> 1) & 1); ++_r) pg8::gemm_phase<EpiRes>((LAS unsigned char*)lds, g, S, E);
        const int nun = (MR / 256) * (2 * D / 256), rounds = (nun + G - 1) / G, first_idle = nun - (rounds - 1) * G;
        if (first_idle < G) { if ((int)blockIdx.x >= first_idle) { const int tid = ltid(); late_transposes(a, lds, tid, ((int)blockIdx.x - first_idle) * 8 + (tid >> 6), (G - first_idle) * 8); } }
        else { const int tid = ltid(); late_transposes(a, lds, tid, (int)blockIdx.x * 8 + (tid >> 6), G * 8); }
    }
    SEAM(5);
    if (IN(6)) {
        KArgs a = kargs(); const int G = gridDim.x, tid = ltid(), lane = tid & 63, wave = tid >> 6;
        for (int _r = 0; _r < REPLN; ++_r) for (int row = blockIdx.x * 8 + wave; row < MR; row += 2 * G * 8) {
            const int rowb = row + G * 8; const bool hasB = rowb < MR; const int rb = hasB ? rowb : row;
            ln2_bf16<false>(WSP(const bf16_t*, WS_PRE) + (size_t)row * D, WSP(const bf16_t*, WS_Z) + (size_t)row * D, WSP(const bf16_t*, WS_PRE) + (size_t)rb * D, WSP(const bf16_t*, WS_Z) + (size_t)rb * D, hasB,
                            a->in[11], a->in[12], WSP(bf16_t*, WS_H) + (size_t)row * D, WSP(bf16_t*, WS_H) + (size_t)rb * D, lane);
        }
    }
    SEAM(6);
    if (IN(7)) {
        KArgs a = kargs(); const int G = gridDim.x, c = (int)blockIdx.x;
        const pg8::Gemm gu{WSP(const bf16_t*, WS_H), WSP(const bf16_t*, WS_WGU), D, D, 2 * FF / 256, 0};
        const pg8::Gemm gd{WSP(const bf16_t*, WS_A2), WSP(const bf16_t*, WS_WD), FF, FF / 2, D / 256, (size_t)(FF / 2) * 2};
        const EpiGlu Eu{WSP(bf16_t*, WS_A2)};
        const EpiRes Ed{WSP(bf16_t*, WS_PRE), WSP(const bf16_t*, WS_H), WSP(bf16_t*, WS_PRE2)};
        constexpr int NP = MR / 256;
        pg8::StaticOrder S; S.init(MR - 512, 2 * FF, G, c); S.tailM = 2;
        const int nup = S.total(), nfull = nup / G, ntail = nup - nfull * G;
        int np1 = (G - ntail) / 16; if (np1 > NP - 2) np1 = NP - 2;
        const bool cut = ntail > 0 && ntail % 8 == 0 && (G - ntail) == np1 * 16 && G % 8 == 0 && (nfull * G - S.nwg) >= 0 && (hi - lo > 1);
        S.ilim = cut ? nfull : (1 << 20);
        pg8::gemm_phase<EpiGlu>((LAS unsigned char*)lds, gu, S, Eu);
        if (hi - lo > 1) { KArgs _a = kargs(); xcd_barrier((unsigned*)(_a->ws + WS_BAR), (volatile LAS unsigned*)(lds + LDS_CTL)); }
        if (cut) {
            if (c < ntail) {
                S.i0 = nfull; S.ilim = 1 << 20; pg8::gemm_phase<EpiGlu>((LAS unsigned char*)lds, gu, S, Eu);
                const int tid = ltid();
                unsigned* head = (unsigned*)(a->ws + WS_BAR) + 32;
                volatile LAS unsigned* qw = (volatile LAS unsigned*)(lds + LDS_CTL) + 2;
                if (tid == 0) *qw = __hip_atomic_fetch_add(head, 1u, __ATOMIC_RELAXED, __HIP_MEMORY_SCOPE_AGENT);
                __syncthreads();
                const int q = (int)*qw;
                if (q < 512) retS_item<1>(lds, nullptr, a->in[2], a->out, nullptr, WSP(bf16_t*, WS_SKV), q, tid);
            }
            else { pg8::StaticOrder T; T.init(np1 * 256, 2 * D, G - ntail, c - ntail); pg8::gemm_phase<EpiRes>((LAS unsigned char*)lds, gd, T, Ed); }
            { KArgs _a = kargs(); xcd_barrier((unsigned*)(_a->ws + WS_BAR), (volatile LAS unsigned*)(lds + LDS_CTL)); }
        }
        {
            const int p0 = cut ? np1 : 0;
            pg8::StaticOrder T; T.init((NP - p0) * 256, 2 * D, G, c); T.pm0 = p0;
            pg8::gemm_phase<EpiRes>((LAS unsigned char*)lds, gd, T, Ed);
        }
        {
            const int tid = ltid();
            unsigned* head = (unsigned*)(a->ws + WS_BAR) + 32;
            volatile LAS unsigned* qw = (volatile LAS unsigned*)(lds + LDS_CTL) + 2;
            for (;;) {
                if (tid == 0) *qw = __hip_atomic_fetch_add(head, 1u, __ATOMIC_RELAXED, __HIP_MEMORY_SCOPE_AGENT);
                __syncthreads();
                const int q = (int)*qw;
                if (q >= 512) break;
                retS_item<1>(lds, nullptr, a->in[2], a->out, nullptr, WSP(bf16_t*, WS_SKV), q, tid);
            }
        }
    }
    SEAM(8);
    if (IN(9)) {
        KArgs a = kargs(); const int G = gridDim.x, tid = ltid(), lane = tid & 63, wave = tid >> 6;
        for (int _r = 0; _r < REPLN; ++_r) for (int row = blockIdx.x * 8 + wave; row < MR; row += 2 * G * 8) {
            const int rowb = row + G * 8; const bool hasB = rowb < MR; const int rb = hasB ? rowb : row;
            float* da = row < SROW ? a->out + OFF_YP + (size_t)row * D : a->out + OFF_YS + (size_t)(row - SROW) * D;
            float* db = rb < SROW ? a->out + OFF_YP + (size_t)rb * D : a->out + OFF_YS + (size_t)(rb - SROW) * D;
            ln2_bf16<true>(WSP(const bf16_t*, WS_PRE) + (size_t)row * D, WSP(const bf16_t*, WS_PRE2) + (size_t)row * D, WSP(const bf16_t*, WS_PRE) + (size_t)rb * D, WSP(const bf16_t*, WS_PRE2) + (size_t)rb * D, hasB,
                           a->in[16], a->in[17], da, db, lane);
        }
    }
#undef IN
#undef SEAM
#undef WSP
}

extern "C" void kernel_launch(void* const* d_in, const int* in_sizes, int n_in, void* d_out, int out_size, void* d_ws, size_t ws_size, hipStream_t stream) {
    static int grid = 0;
    if (grid == 0) {
        if (n_in != 18 || ws_size < WS_END) { fprintf(stderr, "kernel_launch: unexpected n_in %d / ws_size %zu (need %zu)\n", n_in, ws_size, (size_t)WS_END); grid = -1; return; }
        int dev = 0, cus = 0, per_cu = 0;
        (void)hipGetDevice(&dev);
        (void)hipDeviceGetAttribute(&cus, hipDeviceAttributeMultiprocessorCount, dev);
        (void)hipFuncSetAttribute((const void*)fwd, hipFuncAttributeMaxDynamicSharedMemorySize, LDS_BYTES);
        (void)hipOccupancyMaxActiveBlocksPerMultiprocessor(&per_cu, (const void*)fwd, 512, LDS_BYTES);
        if (per_cu < 1) { fprintf(stderr, "kernel_launch: occupancy query reports %d blocks per CU\n", per_cu); per_cu = 1; }
        grid = cus * 1;
        (void)hipGetLastError();
    }
    if (grid < 0) return;
    Args a{};
    for (int i = 0; i < 18; ++i) a.in[i] = (const float*)d_in[i];
    a.out = (float*)d_out; a.ws = (unsigned char*)d_ws;
#if N_LAUNCH_MODE == 0
    (void)hipMemsetAsync((char*)d_ws + WS_BAR, 0, 3456 * 4, stream);
    a.ph_lo = 0; a.ph_hi = NPHASE;
    void* args[] = {&a};
    hipError_t e = hipLaunchCooperativeKernel((const void*)fwd, dim3(grid), dim3(512), args, LDS_BYTES, stream);
    if (e != hipSuccess) fprintf(stderr, "cooperative launch failed: %s (grid %d)\n", hipGetErrorString(e), grid);
#else
    for (int p = 0; p < NPHASE; ++p) {
        a.ph_lo = p; a.ph_hi = p + 1;
        void* args[] = {&a};
        hipError_t e = hipLaunchCooperativeKernel((const void*)fwd, dim3(grid), dim3(512), args, LDS_BYTES, stream);
        if (e != hipSuccess) fprintf(stderr, "launch %d failed: %s (grid %d)\n", p, hipGetErrorString(e), grid);
    }
#endif
}
```

```cpp
#include <hip/hip_runtime.h>
#include <hip/hip_cooperative_groups.h>
#include <cstdio>
namespace cg = cooperative_groups;

#ifndef N_LAUNCH_MODE
#define N_LAUNCH_MODE 0
#endif

#ifndef REP0
#define REP0 1
#endif
#ifndef REPMIX
#define REPMIX 1
#endif
#ifndef REPLN
#define REPLN 1
#endif
#ifndef REPG
#define REPG 0
#endif
#ifndef REPSYNC
#define REPSYNC 1
#endif
#define LAS __attribute__((address_space(3)))
typedef unsigned short bf16_t;
typedef short bf16x8 __attribute__((ext_vector_type(8)));
typedef float f32x4 __attribute__((ext_vector_type(4)));
typedef unsigned u32x4 __attribute__((ext_vector_type(4)));
typedef unsigned u32x2 __attribute__((ext_vector_type(2)));

constexpr int D = 2048, LP = 2064, MS = 1024, M = 9280, MPAD = 9472, PW = 5376, FF = 5632;
constexpr int SROW = 8192, MR = 9216, METAROW = 9216;
constexpr int ZQ = 0, ZK = 1024, ZV = 2048, ZG = 3072, ZSQ = 4096, ZSK = 5120, ZSV = 5248;
constexpr int NPOS = 2072;
constexpr float ALPHA = 1.189207115002721f, LN_EPS = 1e-5f;
constexpr size_t OFF_YP = 0, OFF_YS = 16777216, OFF_RSP = 18874368, OFF_KP = 19922944, OFF_VP = 19988480,
                 OFF_RSS = 20054016, OFF_KS = 53608448, OFF_VS = 55705600;
constexpr size_t WS_WIN = 0;
constexpr size_t WS_WO = WS_WIN + (size_t)PW * D * 2;
constexpr size_t WS_WGU = WS_WO + (size_t)D * D * 2;
constexpr size_t WS_MIX = WS_WGU + (size_t)2 * FF * D * 2;
constexpr size_t WS_WD = WS_MIX + (size_t)MPAD * D * 2;
constexpr size_t WS_H = WS_WD + (size_t)D * FF * 2;
constexpr size_t WS_PRE = WS_H + (size_t)MPAD * D * 2;
constexpr size_t WS_Z = WS_PRE + (size_t)MPAD * D * 4;
constexpr size_t WS_U = WS_Z + (size_t)MPAD * PW * 2;
constexpr size_t WS_SB = WS_U + (size_t)272 * 65536 * 4;
constexpr size_t WS_TAB = WS_SB + (size_t)256 * 65536 * 2;
constexpr size_t WS_BAR = WS_TAB + (((size_t)NPOS * 128 * 4 * 2 + (size_t)NPOS * 8 * 4 * 2 + 255) / 256) * 256;
constexpr size_t WS_SKV = WS_BAR + 16384;
constexpr size_t WS_END = WS_SKV + (size_t)512 * 2 * 8 * 256 * 2;
constexpr size_t WS_A2 = WS_Z;
constexpr size_t WS_PRE2 = WS_MIX;
static_assert((size_t)MPAD * D * 2 <= WS_WD - WS_MIX, "PRE2 alias");
static_assert((size_t)MPAD * FF * 2 <= WS_SB - WS_Z, "A2 alias");
constexpr int LDS_BYTES = 147456, LDS_CTL = 147440;

__device__ __forceinline__ float lg2gamma(int h) {
    return h == 0 ? -0.04580368961312479f : h == 1 ? -0.02272007650008353f : h == 2 ? -0.011315313227834146f : -0.005646563141142063f;
}
__device__ __forceinline__ int prow(int b, int t) { return t < 16 ? METAROW + b * 16 + t : b * 2048 + (t - 16); }
__device__ __forceinline__ float fexp2(float x) { return __builtin_amdgcn_exp2f(x); }
__device__ __forceinline__ float fexp(float x) { return __builtin_amdgcn_exp2f(x * 1.4426950408889634f); }
__device__ __forceinline__ float bf2f(unsigned b) { return __uint_as_float(b << 16); }
__device__ __forceinline__ unsigned cvt_pk_bf16(float lo, float hi) { unsigned r; asm volatile("v_cvt_pk_bf16_f32 %0, %1, %2" : "=v"(r) : "v"(lo), "v"(hi)); return r; }
__device__ __forceinline__ bf16_t f2bf(float f) { return (bf16_t)(cvt_pk_bf16(f, 0.f) & 0xffffu); }
__device__ __forceinline__ float silu(float x) { return x * __builtin_amdgcn_rcpf(1.f + fexp(-x)); }
__device__ __forceinline__ f32x4 ld4(const float* p, int i) { return ((const f32x4*)p)[i]; }
__device__ __forceinline__ f32x4 ld4(const bf16_t* p, int i) { const u32x2 r = ((const u32x2*)p)[i]; return (f32x4){bf2f(r.x & 0xffffu), bf2f(r.x >> 16), bf2f(r.y & 0xffffu), bf2f(r.y >> 16)}; }
__device__ __forceinline__ void unpack8(const u32x4 r, f32x4& lo, f32x4& hi) {
    lo = (f32x4){bf2f(r.x & 0xffffu), bf2f(r.x >> 16), bf2f(r.y & 0xffffu), bf2f(r.y >> 16)};
    hi = (f32x4){bf2f(r.z & 0xffffu), bf2f(r.z >> 16), bf2f(r.w & 0xffffu), bf2f(r.w >> 16)};
}
__device__ __forceinline__ float wave_sum(float v) {
#pragma unroll
    for (int o = 1; o < 64; o <<= 1) v += __shfl_xor(v, o);
    return v;
}
__device__ __forceinline__ f32x4 mfma16(bf16x8 a, bf16x8 b, f32x4 c) { return __builtin_amdgcn_mfma_f32_16x16x32_bf16(a, b, c, 0, 0, 0); }
__device__ __forceinline__ bf16x8 as_bf16x8(u32x4 v) { union { u32x4 u; bf16x8 b; } x; x.u = v; return x.b; }

struct Args { const float* in[18]; float* out; unsigned char* ws; int ph_lo, ph_hi; };
typedef const __attribute__((address_space(4))) Args* KArgs;
__device__ __forceinline__ KArgs kargs() { KArgs p = (KArgs)__builtin_amdgcn_kernarg_segment_ptr(); asm volatile("" : "+s"(p)); return p; }
__device__ __forceinline__ int ltid() { int t = threadIdx.x; asm volatile("" : "+v"(t)); return t; }


#define XB_TMO      128
#define XB_XCNT(j)  (256  + 64 * (j))
#define XB_XSUB(j)  (1280 + 64 * (j))
#define XB_XGEN(j)  (2304 + 64 * (j))
#define XB_TOP      3328
#define XB_TOPGEN   3392
#define XCD_BAR_WORDS 3456
#define XB_SPIN_CAP (1u << 18)
__device__ __forceinline__ unsigned xb_ld(unsigned* p)              { return __hip_atomic_load(p, __ATOMIC_RELAXED, __HIP_MEMORY_SCOPE_AGENT); }
__device__ __forceinline__ unsigned xb_add(unsigned* p, unsigned v) { return __hip_atomic_fetch_add(p, v, __ATOMIC_RELAXED, __HIP_MEMORY_SCOPE_AGENT); }
__device__ __forceinline__ unsigned xb_xcc_id() { return (unsigned)__builtin_amdgcn_s_getreg((3 << 11) | 20) & 0xFu; }
#define XB_SPIN(cond, bar) do { unsigned _sp = 0; while (cond) { __builtin_amdgcn_s_sleep(1); \
    if ((++_sp & 255u) == 0u) { if (xb_ld(&(bar)[XB_TMO])) break; if (_sp > XB_SPIN_CAP) { atomicAdd(&(bar)[XB_TMO], 1u); break; } } } } while (0)
__device__ __forceinline__ void xcd_barrier_complete(unsigned* bar, unsigned x, unsigned& nloc, unsigned& nx) {
    const unsigned G = gridDim.x * gridDim.y * gridDim.z;
    unsigned sum, cnt, mine, sp = 0u;
    for (;;) {
        sum = 0u; cnt = 0u; mine = 0u;
#pragma unroll
        for (unsigned j = 0; j < 16; ++j) { const unsigned c = xb_ld(&bar[XB_XCNT(j)]); sum += c; cnt += (c > 0u) ? 1u : 0u; mine = (j == x) ? c : mine; }
        if (sum == G) break;
        __builtin_amdgcn_s_sleep(1);
        if ((++sp & 255u) == 0u) { if (xb_ld(&bar[XB_TMO])) break; if (sp > XB_SPIN_CAP) { atomicAdd(&bar[XB_TMO], 1u); break; } }
    }
    nloc = mine > 0u ? mine : 1u; nx = cnt > 0u ? cnt : 1u;
}
__device__ __forceinline__ void xcd_barrier(unsigned* bar, volatile LAS unsigned* st) {
    asm volatile("s_waitcnt vmcnt(0)" ::: "memory");
    __syncthreads();
    if (threadIdx.x == 0) {
        const unsigned x = xb_xcc_id();
        __builtin_amdgcn_s_waitcnt(0);
        unsigned nloc = st[0], nx = st[1];
        if (nloc == 0u) { xcd_barrier_complete(bar, x, nloc, nx); st[0] = nloc; st[1] = nx; }
        const unsigned old = xb_add(&bar[XB_XSUB(x)], 1u);
        const unsigned gen = old / nloc;
        if (old + 1u == (gen + 1u) * nloc) {
            __builtin_amdgcn_fence(__ATOMIC_RELEASE, "agent");
            asm volatile("s_waitcnt vmcnt(0)" ::: "memory");
            const unsigned og = xb_add(&bar[XB_TOP], 1u);
            const unsigned tg = og / nx;
            if (og + 1u == (tg + 1u) * nx) xb_add(&bar[XB_TOPGEN], 1u);
            else XB_SPIN(xb_ld(&bar[XB_TOPGEN]) == tg, bar);
            __builtin_amdgcn_fence(__ATOMIC_ACQUIRE, "agent");
            xb_add(&bar[XB_XGEN(x)], 1u);
            asm volatile("s_waitcnt vmcnt(0)" ::: "memory");
        } else {
            XB_SPIN(xb_ld(&bar[XB_XGEN(x)]) == gen, bar);
            __builtin_amdgcn_fence(__ATOMIC_ACQUIRE, "agent");
            asm volatile("s_waitcnt vmcnt(0)" ::: "memory");
        }
    }
    __syncthreads();
}

namespace pg8 {
constexpr int BM = 256, BK = 64, HALF = 128, HTB = HALF * BK * 2, STAGE_BYTES = 8 * HTB, NXCD = 8, WGM = 4;
__device__ __forceinline__ int lds_byte(int r, int c) { const int st = (r >> 4) * 2 + (c >> 5), rr = r & 15, cc = c & 31, ob = rr * 64 + cc * 2; return st * 1024 + (ob ^ (((ob >> 9) & 1) << 5)); }
__device__ __forceinline__ void stage_rc(int b, int& R, int& C) { const int st = b / 1024, sb = b % 1024, swz = sb ^ (((sb >> 9) & 1) << 5); R = (st >> 1) * 16 + swz / 64; C = (st & 1) * 32 + (swz % 64) / 2; }
__device__ __forceinline__ int perm32(int rho) { const int n = rho >> 4, i = rho & 15; return 8 * (i >> 2) + 4 * n + (i & 3); }
struct Unit { int pm, pn; };
struct Gemm { const bf16_t* A; const bf16_t* Bt; int ld, K, nNr; size_t ksb; };
struct StaticOrder {
    int nM, nN, nwg, G, c, nextra;
    int i0, ilim;
    int tailM;
    int pm0;
    __device__ __forceinline__ void init(int M_, int N_, int G_, int c_, int nextra_ = 0) { nM = M_ / BM; nN = N_ / BM; nwg = nM * nN; G = G_; c = c_; nextra = nextra_; i0 = 0; ilim = 1 << 20; tailM = 0; pm0 = 0; }
    __device__ __forceinline__ int total() const { return nwg + nextra + tailM * nN; }
    __device__ __forceinline__ void tile(int wgid, int& pm, int& pn) const {
        { const int q = nwg / NXCD, r = nwg % NXCD, xcd = wgid % NXCD, off = wgid / NXCD; wgid = (xcd < r ? xcd * (q + 1) : r * (q + 1) + (xcd - r) * q) + off; }
        const int nig = WGM * nN, gid = wgid / nig, fm = gid * WGM, gsz = (nM - fm) < WGM ? (nM - fm) : WGM;
        pm = fm + ((wgid % nig) % gsz); pn = (wgid % nig) / gsz;
    }
    __device__ __forceinline__ bool next(int i, Unit& u) const {
        const int ii = i + i0; if (ii >= ilim) return false;
        const long L = (long)ii * G + c; if (L >= total()) return false;
        if (L >= nwg && tailM > 0) { const int x = (int)L - nwg; u.pm = pm0 + nM + x % tailM; u.pn = x / tailM; return true; }
        if (L >= nwg) { const int x = (int)L - nwg; u.pm = nM; u.pn = x < 8 ? 4 + x : 20; return true; }
        tile((int)L, u.pm, u.pn); u.pm += pm0; return true;
    }
};

template <class Epi>
__device__ __forceinline__ void gemm_phase(LAS unsigned char* lds, const Gemm g, const StaticOrder& S, const Epi& E) {
    const int tid = ltid(), wid = __builtin_amdgcn_readfirstlane(tid >> 6), lane = tid & 63, wr = wid >> 2, wc = wid & 3, fr = lane & 15, fq = lane >> 4;
    const int K = g.K, nt = K / BK;
    const int ld = g.ld;
    unsigned voffA[2], voffB[2];
#pragma unroll
    for (int i = 0; i < 2; ++i) { int R, C; stage_rc(tid * 16 + i * 8192, R, C); const int Rb = Epi::PERM ? ((R & ~31) + perm32(R & 31)) : R;
        voffA[i] = (unsigned)(R * ld + C) * 2u; voffB[i] = (unsigned)(Rb * ld + C) * 2u; }
    const size_t kstep = (size_t)(BK * 2);
    const size_t hstep = (size_t)HALF * ld * 2;
    const size_t tstep = 2 * hstep;
    const unsigned ldsw = (unsigned)wid * 1024u;
    const int aoff = lds_byte(wr * 64 + fr, fq * 8), boff = lds_byte(wc * 32 + fr, fq * 8);
#define PG8_SA(b, h) (((b) * 2 + (h)) * HTB)
#define PG8_SB(b, h) ((4 + (b) * 2 + (h)) * HTB)
#define PG8_STAGE(bufoff, gbase, voff) do { _Pragma("unroll") for (int _i = 0; _i < 2; ++_i) \
        __builtin_amdgcn_global_load_lds((const unsigned*)((const char*)(gbase) + (voff)[_i]), (LAS unsigned*)(lds + (bufoff) + ldsw + _i * 8192), 16, 0, 0); } while (0)
#define PG8_LDA(dst, b, h) do { _Pragma("unroll") for (int m = 0; m < 4; ++m) _Pragma("unroll") for (int k = 0; k < 2; ++k) dst[m][k] = *(const LAS bf16x8*)(lds + PG8_SA(b, h) + aoff + m * 2048 + k * 1024); } while (0)
#define PG8_LDB(dst, b, h) do { _Pragma("unroll") for (int n = 0; n < 2; ++n) _Pragma("unroll") for (int k = 0; k < 2; ++k) dst[n][k] = *(const LAS bf16x8*)(lds + PG8_SB(b, h) + boff + n * 2048 + k * 1024); } while (0)
#define PG8_MMA(ai, bj, At, Bt) do { __builtin_amdgcn_s_setprio(1); _Pragma("unroll") for (int m = 0; m < 4; ++m) _Pragma("unroll") for (int n = 0; n < 2; ++n) _Pragma("unroll") for (int k = 0; k < 2; ++k) \
        acc[ai][bj][m][n] = __builtin_amdgcn_mfma_f32_16x16x32_bf16(Bt[n][k], At[m][k], acc[ai][bj][m][n], 0, 0, 0); __builtin_amdgcn_s_setprio(0); } while (0)
#define PG8_WAIT_V(n) asm volatile("s_waitcnt vmcnt(" #n ")" ::: "memory")
#define PG8_WAIT_L(n) asm volatile("s_waitcnt lgkmcnt(" #n ")" ::: "memory")
#define PG8_BAR __builtin_amdgcn_s_barrier()
#define PG8_SCHED __builtin_amdgcn_sched_barrier(0)
    Unit cur, nxt; int ui = 0;
    if (!S.next(0, cur)) return;
    f32x4 acc[2][2][4][2];
#pragma unroll
    for (int a = 0; a < 2; ++a)
#pragma unroll
        for (int b = 0; b < 2; ++b)
#pragma unroll
            for (int m = 0; m < 4; ++m)
#pragma unroll
                for (int n = 0; n < 2; ++n) acc[a][b][m][n] = (f32x4){0.f, 0.f, 0.f, 0.f};
    bf16x8 At[4][2], B0[2][2], B1[2][2];
#define PG8_APTR(u) ((const char*)g.A + (size_t)(u).pm * tstep + (size_t)((u).pn / g.nNr) * g.ksb)
#define PG8_BPTR(u) ((const char*)g.Bt + (size_t)((u).pn % g.nNr) * tstep + (size_t)((u).pn / g.nNr) * g.ksb)
    const char* cA = PG8_APTR(cur); const char* cB = PG8_BPTR(cur);
    PG8_STAGE(PG8_SB(0, 0), cB, voffB); PG8_STAGE(PG8_SA(0, 0), cA, voffA); PG8_STAGE(PG8_SB(0, 1), cB + hstep, voffB); PG8_STAGE(PG8_SA(0, 1), cA + hstep, voffA);
    if (wr == 1) PG8_BAR;
    PG8_WAIT_V(4); PG8_BAR;
    PG8_STAGE(PG8_SB(1, 0), cB + kstep, voffB); PG8_STAGE(PG8_SA(1, 0), cA + kstep, voffA); PG8_STAGE(PG8_SB(1, 1), cB + hstep + kstep, voffB);
    PG8_WAIT_V(6); PG8_BAR;
    for (;;) {
        const bool has_next = S.next(ui + 1, nxt);
        const char* nA = has_next ? PG8_APTR(nxt) : cA; const char* nB = has_next ? PG8_BPTR(nxt) : cB;
        for (int t = 0; t < nt; t += 2) {
            const bool last = (t == nt - 2);
            const char* a1 = cA + (size_t)(t + 1) * kstep;
            const char* a2 = last ? nA : cA + (size_t)(t + 2) * kstep; const char* b2 = last ? nB : cB + (size_t)(t + 2) * kstep;
            const char* a3 = a2 + kstep; const char* b3 = b2 + kstep;
            PG8_LDB(B0, 0, 0); PG8_SCHED; PG8_LDA(At, 0, 0); PG8_STAGE(PG8_SA(1, 1), a1 + hstep, voffA);
            PG8_WAIT_L(8); PG8_BAR; PG8_WAIT_L(0); PG8_MMA(0, 0, At, B0); PG8_BAR; PG8_SCHED;
            PG8_LDB(B1, 0, 1); PG8_STAGE(PG8_SB(0, 0), b2, voffB);
            PG8_BAR; PG8_WAIT_L(0); PG8_MMA(0, 1, At, B1); PG8_BAR;
            PG8_LDA(At, 0, 1); PG8_STAGE(PG8_SA(0, 0), a2, voffA);
            PG8_BAR; PG8_WAIT_L(0); PG8_MMA(1, 0, At, B0); PG8_BAR; PG8_SCHED;
            PG8_STAGE(PG8_SB(0, 1), b2 + hstep, voffB);
            PG8_WAIT_V(6); PG8_BAR; PG8_MMA(1, 1, At, B1); PG8_BAR;
            PG8_LDB(B0, 1, 0); PG8_SCHED; PG8_LDA(At, 1, 0); PG8_STAGE(PG8_SA(0, 1), a2 + hstep, voffA);
            PG8_WAIT_L(8); PG8_BAR; PG8_WAIT_L(0); PG8_MMA(0, 0, At, B0); PG8_BAR; PG8_SCHED;
            PG8_LDB(B1, 1, 1); PG8_STAGE(PG8_SB(1, 0), b3, voffB);
            PG8_BAR; PG8_WAIT_L(0); PG8_MMA(0, 1, At, B1); PG8_BAR;
            PG8_LDA(At, 1, 1); PG8_STAGE(PG8_SA(1, 0), a3, voffA);
            PG8_BAR; PG8_WAIT_L(0); PG8_MMA(1, 0, At, B0); PG8_BAR; PG8_SCHED;
            PG8_STAGE(PG8_SB(1, 1), b3 + hstep, voffB);
            PG8_WAIT_V(6); PG8_BAR; PG8_MMA(1, 1, At, B1); PG8_BAR;
        }
        E(acc, cur, wr, wc, fr, fq);
        if (!has_next) break;
#pragma unroll
        for (int a = 0; a < 2; ++a)
#pragma unroll
            for (int b = 0; b < 2; ++b)
#pragma unroll
                for (int m = 0; m < 4; ++m)
#pragma unroll
                    for (int n = 0; n < 2; ++n) acc[a][b][m][n] = (f32x4){0.f, 0.f, 0.f, 0.f};
        cur = nxt; cA = nA; cB = nB; ++ui;
    }
    PG8_WAIT_V(0);
    if (wr == 0) PG8_BAR;
    PG8_BAR;
#undef PG8_APTR
#undef PG8_BPTR
#undef PG8_SA
#undef PG8_SB
#undef PG8_STAGE
#undef PG8_LDA
#undef PG8_LDB
#undef PG8_MMA
#undef PG8_WAIT_V
#undef PG8_WAIT_L
#undef PG8_BAR
#undef PG8_SCHED
}
}

struct EpiIn {
    static constexpr bool PERM = true;
    bf16_t* Z; const float* cosR; const float* sinR; const float* cosS; const float* sinS; float* out;
    __device__ __forceinline__ void operator()(const f32x4 (&acc)[2][2][4][2], const pg8::Unit& u, int wr, int wc, int fr, int fq) const {
        const int pn = u.pn;
#pragma unroll
        for (int ai = 0; ai < 2; ++ai) {
            f32x4 tc0[4], tc1[4], ts0[4], ts1[4];
            if (pn < 8 || pn >= 16) {
#pragma unroll
                for (int m = 0; m < 4; ++m) {
                    const int row = u.pm * 256 + ai * 128 + wr * 64 + m * 16 + fr; int tab = 0;
                    if (row < SROW) tab = 16 + (row & 2047); else if (row < MR) tab = LP + ((row - SROW) & 7); else if (row < M) tab = (row - METAROW) & 15;
                    const float* cp_ = pn < 8 ? cosR + tab * 128 + wc * 32 + 8 * fq : cosS + tab * 8;
                    const float* sp_ = pn < 8 ? sinR + tab * 128 + wc * 32 + 8 * fq : sinS + tab * 8;
                    tc0[m] = *(const f32x4*)cp_; tc1[m] = *(const f32x4*)(cp_ + 4); ts0[m] = *(const f32x4*)sp_; ts1[m] = *(const f32x4*)(sp_ + 4);
                }
            }
#pragma unroll
            for (int m = 0; m < 4; ++m) {
                const int row = u.pm * 256 + ai * 128 + wr * 64 + m * 16 + fr;
                int b = 0, t = 0, tab = 0; const bool isP = row < SROW || (row >= METAROW && row < M), isS = (row >= SROW) && (row < MR);
                if (row < SROW) { b = row >> 11; t = 16 + (row & 2047); tab = t; } else if (isS) { const int s = row - SROW; b = s >> 3; t = s & 7; tab = LP + t; }
                else if (isP) { const int mrow = row - METAROW; b = mrow >> 4; t = mrow & 15; tab = t; }
                f32x4 o00 = acc[ai][0][m][0], o01 = acc[ai][0][m][1], o10 = acc[ai][1][m][0], o11 = acc[ai][1][m][1];
                if (pn < 8) {
                    const f32x4 c0 = tc0[m], c1 = tc1[m], s0 = ts0[m], s1 = ts1[m];
                    const float sc = pn >= 4 ? 0.0625f : 1.0f;
                    const f32x4 a0 = o00, a1 = o01, b0 = o10, b1 = o11;
                    o00 = (a0 * c0 - b0 * s0) * sc; o10 = (b0 * c0 + a0 * s0) * sc;
                    o01 = (a1 * c1 - b1 * s1) * sc; o11 = (b1 * c1 + a1 * s1) * sc;
                } else if (pn < 12) {
                } else if (pn < 16) {
#pragma unroll
                    for (int j = 0; j < 4; ++j) { o00[j] = silu(o00[j]); o01[j] = silu(o01[j]); o10[j] = silu(o10[j]); o11[j] = silu(o11[j]); }
                } else {
                    const f32x4 c0 = tc0[m], c1 = tc1[m], s0 = ts0[m], s1 = ts1[m];
                    const bool rot = ((wc & 1) == 0) && (fq < 2); const float sg = fq == 0 ? -1.f : 1.f;
                    f32x4 p;
#pragma unroll
                    for (int j = 0; j < 4; ++j) p[j] = __shfl_xor(o00[j], 16);
                    if (rot) o00 = o00 * c0 + p * s0 * sg;
#pragma unroll
                    for (int j = 0; j < 4; ++j) p[j] = __shfl_xor(o01[j], 16);
                    if (rot) o01 = o01 * c1 + p * s1 * sg;
                    if (pn < 20) {
#pragma unroll
                        for (int j = 0; j < 4; ++j) p[j] = __shfl_xor(o10[j], 16);
                        if (rot) o10 = o10 * c0 + p * s0 * sg;
#pragma unroll
                        for (int j = 0; j < 4; ++j) p[j] = __shfl_xor(o11[j], 16);
                        if (rot) o11 = o11 * c1 + p * s1 * sg;
                        o00 *= 0.125f; o01 *= 0.125f; o10 *= 0.125f; o11 *= 0.125f;
                    } else {
                        const int cc = wc * 32 + 8 * fq;
                        if (isP && t >= LP - 128) {
                            float* kp = out + OFF_KP + ((size_t)(b * 128 + (t - (LP - 128))) * 128 + cc);
                            float* vp = out + OFF_VP + ((size_t)(b * 128 + (t - (LP - 128))) * 128 + cc);
                            *(f32x4*)kp = o00; *(f32x4*)(kp + 4) = o01; *(f32x4*)vp = o10; *(f32x4*)(vp + 4) = o11;
                        } else if (isS) {
                            float* kp = out + OFF_KS + ((size_t)(b * 128 + 120 + t) * 128 + cc);
                            float* vp = out + OFF_VS + ((size_t)(b * 128 + 120 + t) * 128 + cc);
                            *(f32x4*)kp = o00; *(f32x4*)(kp + 4) = o01; *(f32x4*)vp = o10; *(f32x4*)(vp + 4) = o11;
                        }
                    }
                }
                bf16_t* zrow = Z + (size_t)row * PW + pn * 256 + wc * 32 + 8 * fq;
                u32x4 w0, w1;
                w0.x = cvt_pk_bf16(o00[0], o00[1]); w0.y = cvt_pk_bf16(o00[2], o00[3]); w0.z = cvt_pk_bf16(o01[0], o01[1]); w0.w = cvt_pk_bf16(o01[2], o01[3]);
                w1.x = cvt_pk_bf16(o10[0], o10[1]); w1.y = cvt_pk_bf16(o10[2], o10[3]); w1.z = cvt_pk_bf16(o11[0], o11[1]); w1.w = cvt_pk_bf16(o11[2], o11[3]);
                *(u32x4*)zrow = w0; *(u32x4*)(zrow + 128) = w1;
            }
        }
    }
};
struct EpiRes {
    static constexpr bool PERM = true;
    bf16_t* PRE; const bf16_t* R; bf16_t* PRE2;
    __device__ __forceinline__ void operator()(const f32x4 (&acc)[2][2][4][2], const pg8::Unit& u, int wr, int wc, int fr, int fq) const {
        const bool second = u.pn >= 8; const int pn = u.pn & 7; bf16_t* dst = second ? PRE2 : PRE;
        u32x4 rr[2][4][2];
        if (!second) {
#pragma unroll
            for (int ai = 0; ai < 2; ++ai)
#pragma unroll
                for (int m = 0; m < 4; ++m)
#pragma unroll
                    for (int bj = 0; bj < 2; ++bj) rr[ai][m][bj] = *(const u32x4*)(R + (size_t)(u.pm * 256 + ai * 128 + wr * 64 + m * 16 + fr) * D + pn * 256 + wc * 32 + 8 * fq + bj * 128);
        }
#pragma unroll
        for (int ai = 0; ai < 2; ++ai)
#pragma unroll
            for (int m = 0; m < 4; ++m) {
                const size_t off = (size_t)(u.pm * 256 + ai * 128 + wr * 64 + m * 16 + fr) * D + pn * 256 + wc * 32 + 8 * fq;
#pragma unroll
                for (int bj = 0; bj < 2; ++bj) {
                    f32x4 o0 = acc[ai][bj][m][0], o1 = acc[ai][bj][m][1];
                    if (!second) {
                        const u32x4 r = rr[ai][m][bj];
                        o0 += (f32x4){bf2f(r.x & 0xffffu), bf2f(r.x >> 16), bf2f(r.y & 0xffffu), bf2f(r.y >> 16)} * ALPHA;
                        o1 += (f32x4){bf2f(r.z & 0xffffu), bf2f(r.z >> 16), bf2f(r.w & 0xffffu), bf2f(r.w >> 16)} * ALPHA;
                    }
                    u32x4 w; w.x = cvt_pk_bf16(o0[0], o0[1]); w.y = cvt_pk_bf16(o0[2], o0[3]); w.z = cvt_pk_bf16(o1[0], o1[1]); w.w = cvt_pk_bf16(o1[2], o1[3]);
                    *(u32x4*)(dst + off + bj * 128) = w;
                }
            }
    }
};
typedef float f32x2 __attribute__((ext_vector_type(2)));
__device__ __forceinline__ f32x2 glu_pk(f32x2 g, f32x2 u) {
    const f32x2 t = g * (-1.4426950408889634f);
    f32x2 e; e.x = __builtin_amdgcn_exp2f(t.x); e.y = __builtin_amdgcn_exp2f(t.y);
    const f32x2 d = e + 1.0f;
    f32x2 r; r.x = __builtin_amdgcn_rcpf(d.x); r.y = __builtin_amdgcn_rcpf(d.y);
    return (g * u) * r;
}
struct EpiGlu {
    static constexpr bool PERM = true;
    bf16_t* A2;
    __device__ __forceinline__ void operator()(const f32x4 (&acc)[2][2][4][2], const pg8::Unit& u, int wr, int wc, int fr, int fq) const {
#pragma unroll
        for (int ai = 0; ai < 2; ++ai)
#pragma unroll
            for (int m = 0; m < 4; ++m) {
                const size_t off = (size_t)(u.pm * 256 + ai * 128 + wr * 64 + m * 16 + fr) * FF + u.pn * 128 + wc * 32 + 8 * fq;
                const f32x4 g0 = acc[ai][0][m][0], g1 = acc[ai][0][m][1], u0 = acc[ai][1][m][0], u1 = acc[ai][1][m][1];
                const f32x2 a = glu_pk((f32x2){g0[0], g0[1]}, (f32x2){u0[0], u0[1]}), b = glu_pk((f32x2){g0[2], g0[3]}, (f32x2){u0[2], u0[3]});
                const f32x2 c = glu_pk((f32x2){g1[0], g1[1]}, (f32x2){u1[0], u1[1]}), d = glu_pk((f32x2){g1[2], g1[3]}, (f32x2){u1[2], u1[3]});
                u32x4 w; w.x = cvt_pk_bf16(a.x, a.y); w.y = cvt_pk_bf16(b.x, b.y); w.z = cvt_pk_bf16(c.x, c.y); w.w = cvt_pk_bf16(d.x, d.y);
                *(u32x4*)(A2 + off) = w;
            }
    }
};

__device__ __forceinline__ void transpose_item(const float* W, int K, int N, bf16_t* WT, int k0, int n0, int drow, float* scr, int lane) {
    f32x4 v[16];
#pragma unroll
    for (int i = 0; i < 16; ++i) { const int kk = 4 * i + (lane >> 4), c4 = lane & 15; v[i] = __builtin_nontemporal_load((const f32x4*)(W + (size_t)(k0 + kk) * N + n0 + 4 * c4)); }
#pragma unroll
    for (int i = 0; i < 16; ++i) {
        const int kk = 4 * i + (lane >> 4), c4 = lane & 15;
        float* s = scr + kk * 65 + 4 * c4; s[0] = v[i][0]; s[1] = v[i][1]; s[2] = v[i][2]; s[3] = v[i][3];
    }
    asm volatile("s_waitcnt lgkmcnt(0)" ::: "memory");
    const int c = lane & 7;
#pragma unroll
    for (int jn = 0; jn < 8; ++jn) {
        const int n = (lane >> 3) + 8 * jn; const float* s = scr + (8 * c) * 65 + n;
        u32x4 o; o.x = cvt_pk_bf16(s[0], s[65]); o.y = cvt_pk_bf16(s[130], s[195]); o.z = cvt_pk_bf16(s[260], s[325]); o.w = cvt_pk_bf16(s[390], s[455]);
        *(u32x4*)(WT + (size_t)(drow + n) * K + k0 + 8 * c) = o;
    }
    asm volatile("s_waitcnt lgkmcnt(0)" ::: "memory");
}
template <bool OUTF, bool TWO = false, class TI = float>
__device__ __forceinline__ void ln_row(const TI* xrow, const float* g, const float* bta, void* orow, int lane, const TI* xrow2 = nullptr) {
    f32x4 v[8]; float s = 0.f;
#pragma unroll
    for (int j = 0; j < 8; ++j) { v[j] = ld4(xrow, 64 * j + lane); if (TWO) v[j] += ld4(xrow2, 64 * j + lane); s += (v[j][0] + v[j][1]) + (v[j][2] + v[j][3]); }
    const float mean = wave_sum(s) * (1.f / D); float s2 = 0.f;
#pragma unroll
    for (int j = 0; j < 8; ++j) { v[j] = v[j] - mean; s2 += (v[j][0] * v[j][0] + v[j][1] * v[j][1]) + (v[j][2] * v[j][2] + v[j][3] * v[j][3]); }
    const float rstd = 1.f / sqrtf(wave_sum(s2) * (1.f / D) + LN_EPS);
#pragma unroll
    for (int j = 0; j < 8; ++j) {
        const f32x4 gg = ((const f32x4*)g)[64 * j + lane], bb = ((const f32x4*)bta)[64 * j + lane];
        const f32x4 y = v[j] * rstd * gg + bb;
        if (OUTF) ((f32x4*)orow)[64 * j + lane] = y;
        else { u32x2 w; w.x = cvt_pk_bf16(y[0], y[1]); w.y = cvt_pk_bf16(y[2], y[3]); ((u32x2*)orow)[64 * j + lane] = w; }
    }
}
template <bool OUTF>
__device__ __forceinline__ void ln2_bf16(const bf16_t* xa0, const bf16_t* xa1, const bf16_t* xb0, const bf16_t* xb1, bool hasB,
                                         const float* g, const float* bta, void* oa, void* ob, int lane) {
    u32x4 ra0[4], ra1[4], rb0[4], rb1[4]; f32x4 gg[8], bb[8];
#pragma unroll
    for (int j = 0; j < 4; ++j) { ra0[j] = ((const u32x4*)xa0)[64 * j + lane]; ra1[j] = ((const u32x4*)xa1)[64 * j + lane]; rb0[j] = ((const u32x4*)xb0)[64 * j + lane]; rb1[j] = ((const u32x4*)xb1)[64 * j + lane]; }
#pragma unroll
    for (int j = 0; j < 4; ++j) { gg[2 * j] = ((const f32x4*)g)[2 * (64 * j + lane)]; gg[2 * j + 1] = ((const f32x4*)g)[2 * (64 * j + lane) + 1];
                                  bb[2 * j] = ((const f32x4*)bta)[2 * (64 * j + lane)]; bb[2 * j + 1] = ((const f32x4*)bta)[2 * (64 * j + lane) + 1]; }
    f32x4 va[8], vb[8]; float sa = 0.f, sb = 0.f;
#pragma unroll
    for (int j = 0; j < 4; ++j) {
        f32x4 l0, h0, l1, h1;
        unpack8(ra0[j], l0, h0); unpack8(ra1[j], l1, h1); va[2 * j] = l0 + l1; va[2 * j + 1] = h0 + h1;
        unpack8(rb0[j], l0, h0); unpack8(rb1[j], l1, h1); vb[2 * j] = l0 + l1; vb[2 * j + 1] = h0 + h1;
    }
#pragma unroll
    for (int k = 0; k < 8; ++k) { sa += (va[k][0] + va[k][1]) + (va[k][2] + va[k][3]); sb += (vb[k][0] + vb[k][1]) + (vb[k][2] + vb[k][3]); }
    const float ma = wave_sum(sa) * (1.f / D), mb = wave_sum(sb) * (1.f / D); float qa = 0.f, qb = 0.f;
#pragma unroll
    for (int k = 0; k < 8; ++k) { va[k] = va[k] - ma; vb[k] = vb[k] - mb;
        qa += (va[k][0] * va[k][0] + va[k][1] * va[k][1]) + (va[k][2] * va[k][2] + va[k][3] * va[k][3]);
        qb += (vb[k][0] * vb[k][0] + vb[k][1] * vb[k][1]) + (vb[k][2] * vb[k][2] + vb[k][3] * vb[k][3]); }
    const float ra = 1.f / sqrtf(wave_sum(qa) * (1.f / D) + LN_EPS), rb = 1.f / sqrtf(wave_sum(qb) * (1.f / D) + LN_EPS);
#pragma unroll
    for (int j = 0; j < 4; ++j) {
        const f32x4 ya0 = va[2 * j] * ra * gg[2 * j] + bb[2 * j], ya1 = va[2 * j + 1] * ra * gg[2 * j + 1] + bb[2 * j + 1];
        const f32x4 yb0 = vb[2 * j] * rb * gg[2 * j] + bb[2 * j], yb1 = vb[2 * j + 1] * rb * gg[2 * j + 1] + bb[2 * j + 1];
        if (OUTF) {
            ((f32x4*)oa)[2 * (64 * j + lane)] = ya0; ((f32x4*)oa)[2 * (64 * j + lane) + 1] = ya1;
            if (hasB) { ((f32x4*)ob)[2 * (64 * j + lane)] = yb0; ((f32x4*)ob)[2 * (64 * j + lane) + 1] = yb1; }
        } else {
            u32x4 w; w.x = cvt_pk_bf16(ya0[0], ya0[1]); w.y = cvt_pk_bf16(ya0[2], ya0[3]); w.z = cvt_pk_bf16(ya1[0], ya1[1]); w.w = cvt_pk_bf16(ya1[2], ya1[3]);
            ((u32x4*)oa)[64 * j + lane] = w;
            if (hasB) { u32x4 x; x.x = cvt_pk_bf16(yb0[0], yb0[1]); x.y = cvt_pk_bf16(yb0[2], yb0[3]); x.z = cvt_pk_bf16(yb1[0], yb1[1]); x.w = cvt_pk_bf16(yb1[2], yb1[3]);
                ((u32x4*)ob)[64 * j + lane] = x; }
        }
    }
}
__device__ __forceinline__ void ln2_f32(const float* xa, const float* xb, bool hasB, const float* g, const float* bta, bf16_t* oa, bf16_t* ob, int lane) {
    f32x4 va[8], vb[8]; float sa = 0.f, sb = 0.f;
#pragma unroll
    for (int j = 0; j < 8; ++j) { va[j] = __builtin_nontemporal_load((const f32x4*)xa + 64 * j + lane); vb[j] = __builtin_nontemporal_load((const f32x4*)xb + 64 * j + lane); }
#pragma unroll
    for (int j = 0; j < 8; ++j) { sa += (va[j][0] + va[j][1]) + (va[j][2] + va[j][3]); sb += (vb[j][0] + vb[j][1]) + (vb[j][2] + vb[j][3]); }
    const float ma = wave_sum(sa) * (1.f / D), mb = wave_sum(sb) * (1.f / D); float qa = 0.f, qb = 0.f;
#pragma unroll
    for (int j = 0; j < 8; ++j) { va[j] = va[j] - ma; vb[j] = vb[j] - mb;
        qa += (va[j][0] * va[j][0] + va[j][1] * va[j][1]) + (va[j][2] * va[j][2] + va[j][3] * va[j][3]);
        qb += (vb[j][0] * vb[j][0] + vb[j][1] * vb[j][1]) + (vb[j][2] * vb[j][2] + vb[j][3] * vb[j][3]); }
    const float ra = 1.f / sqrtf(wave_sum(qa) * (1.f / D) + LN_EPS), rb = 1.f / sqrtf(wave_sum(qb) * (1.f / D) + LN_EPS);
#pragma unroll
    for (int j = 0; j < 8; ++j) {
        const f32x4 gg = ((const f32x4*)g)[64 * j + lane], bb = ((const f32x4*)bta)[64 * j + lane];
        const f32x4 ya = va[j] * ra * gg + bb, yb = vb[j] * rb * gg + bb;
        u32x2 w; w.x = cvt_pk_bf16(ya[0], ya[1]); w.y = cvt_pk_bf16(ya[2], ya[3]); ((u32x2*)oa)[64 * j + lane] = w;
        if (hasB) { u32x2 x; x.x = cvt_pk_bf16(yb[0], yb[1]); x.y = cvt_pk_bf16(yb[2], yb[3]); ((u32x2*)ob)[64 * j + lane] = x; }
    }
}
__device__ __forceinline__ void sincos_d(float ang, float& c, float& s) {
    const double a = (double)ang; const double k = rint(a * 0.63661977236758134308);
    double r = fma(-k, 1.5707963267948966192, a); r = fma(-k, 6.123233995736766e-17, r);
    const int q = ((int)k) & 3; const double r2 = r * r;
    const double sp = r * (1.0 + r2 * (-1.0 / 6.0 + r2 * (1.0 / 120.0 + r2 * (-1.0 / 5040.0 + r2 * (1.0 / 362880.0 + r2 * (-1.0 / 39916800.0 + r2 * (1.0 / 6227020800.0)))))));
    const double cp = 1.0 + r2 * (-0.5 + r2 * (1.0 / 24.0 + r2 * (-1.0 / 720.0 + r2 * (1.0 / 40320.0 + r2 * (-1.0 / 3628800.0 + r2 * (1.0 / 479001600.0 + r2 * (-1.0 / 87178291200.0)))))));
    const double ss = (q == 0) ? sp : (q == 1) ? cp : (q == 2) ? -sp : -cp;
    const double cc = (q == 0) ? cp : (q == 1) ? -sp : (q == 2) ? -cp : sp;
    c = (float)cc; s = (float)ss;
}
__device__ __forceinline__ double dpowi(double base, int n) { double r = 1.0, b = base; for (int i = 0; i < 8; ++i) { if (n & 1) r *= b; b *= b; n >>= 1; } return r; }

__device__ __forceinline__ void late_transposes(KArgs a, unsigned char* lds, int tid, int gw, int NGW) {
    const int wave = tid >> 6, lane = tid & 63;
    unsigned char* ws = a->ws;
    float* scr = (float*)(lds + wave * 16896);
    constexpr int I_G = 32 * 88, I_D = 88 * 32;
    for (int it = gw; it < 2 * I_G + I_D; it += NGW) {
        int r = it;
        if (r < I_G) { const int kb = r / 88, nb = r % 88; const int n0 = 64 * nb; transpose_item(a->in[13], D, FF, (bf16_t*)(ws + WS_WGU), 64 * kb, n0, 256 * (n0 >> 7) + (n0 & 127), scr, lane); continue; } r -= I_G;
        if (r < I_G) { const int kb = r / 88, nb = r % 88; const int n0 = 64 * nb; transpose_item(a->in[14], D, FF, (bf16_t*)(ws + WS_WGU), 64 * kb, n0, 256 * (n0 >> 7) + 128 + (n0 & 127), scr, lane); continue; } r -= I_G;
        { const int kb = r / 32, nb = r % 32; transpose_item(a->in[15], FF, D, (bf16_t*)(ws + WS_WD), 64 * kb, 64 * nb, 64 * nb, scr, lane); }
    }
}

__device__ __forceinline__ void shift_item(const float* ck, const float* cv, float* out, int b, int tid) {
    const size_t so = (size_t)b * 128 * 128 + 8 * 128, dst = (size_t)b * 128 * 128;
#pragma unroll
    for (int r = 0; r < 2; ++r) {
        f32x4 kv[4], vv[4];
#pragma unroll
        for (int u = 0; u < 4; ++u) { const int i = tid + 512 * (4 * r + u); if (i < 120 * 32) { kv[u] = __builtin_nontemporal_load((const f32x4*)(ck + so) + i); vv[u] = __builtin_nontemporal_load((const f32x4*)(cv + so) + i); } }
#pragma unroll
        for (int u = 0; u < 4; ++u) { const int i = tid + 512 * (4 * r + u); if (i < 120 * 32) { ((f32x4*)(out + OFF_KS + dst))[i] = kv[u]; ((f32x4*)(out + OFF_VS + dst))[i] = vv[u]; } }
    }
}
__device__ __forceinline__ void phase0(KArgs a, unsigned char* lds, int tid, int G) {
    const int wave = tid >> 6, lane = tid & 63;
    const int gw = blockIdx.x * 8 + wave, NGW = G * 8;
    unsigned char* ws = a->ws;
    float* scr = (float*)(lds + wave * 16896);
    const int gt = blockIdx.x * 512 + tid, NGT = G * 512;
    for (int pass = 0; pass < 2; ++pass) {
    if ((pass == 0) == ((wave & 1) != 0)) {
    float* cosR = (float*)(ws + WS_TAB); float* sinR = cosR + NPOS * 128; float* cosS = sinR + NPOS * 128; float* sinS = cosS + NPOS * 8;
    for (int i = gt; i < NPOS * 128; i += NGT) {
        const int pi = i >> 7, f = i & 127; const int pos = pi < LP ? pi : 16384 + (pi - LP);
        const float inv = (float)dpowi(0.9300449458481392, f);
        float c, s; sincos_d((float)pos * inv, c, s); cosR[i] = c; sinR[i] = s;
    }
    for (int i = gt; i < NPOS * 8; i += NGT) {
        const int pi = i >> 3, f = i & 7; const int pos = pi < LP ? pi : 16384 + (pi - LP);
        const float inv = (float)dpowi(0.19392274474868576, f);
        float c, s; sincos_d((float)pos * inv, c, s); cosS[i] = c; sinS[i] = s;
    }
    } else {
    for (int it = gw; it < 32 * 84 + 32 * 32; it += NGW) {
        if (it < 32 * 84) { const int kb = it / 84, nb = it % 84; transpose_item(a->in[8], D, PW, (bf16_t*)(ws + WS_WIN), 64 * kb, 64 * nb, 64 * nb, scr, lane); }
        else { const int r = it - 32 * 84, kb = r / 32, nb = r % 32; transpose_item(a->in[9], D, D, (bf16_t*)(ws + WS_WO), 64 * kb, 64 * nb, 64 * nb, scr, lane); }
    }
    bf16_t* H = (bf16_t*)(ws + WS_H); bf16_t* MIX = (bf16_t*)(ws + WS_MIX);
    for (int row = M + gw; row < MPAD; row += NGW) {
        const u32x4 z = (u32x4){0u, 0u, 0u, 0u};
#pragma unroll
        for (int j = 0; j < 4; ++j) { ((u32x4*)(H + (size_t)row * D))[64 * j + lane] = z; ((u32x4*)(MIX + (size_t)row * D))[64 * j + lane] = z; }
    }
    for (int row = gw; row < M; row += 2 * NGW) {
        const int rowb = row + NGW; const bool hasB = rowb < M; const int rb = hasB ? rowb : row;
        const float* sa = row < SROW ? a->in[0] + (size_t)row * D : row < MR ? a->in[1] + (size_t)(row - SROW) * D : a->in[5] + (size_t)((row - METAROW) & 15) * D;
        const float* sb = rb < SROW ? a->in[0] + (size_t)rb * D : rb < MR ? a->in[1] + (size_t)(rb - SROW) * D : a->in[5] + (size_t)((rb - METAROW) & 15) * D;
        ln2_f32(sa, sb, hasB, a->in[6], a->in[7], H + (size_t)row * D, H + (size_t)rb * D, lane);
    }
    }
    }
}

__device__ __forceinline__ void retA_item(unsigned char* lds, const bf16_t* Z, bf16_t* U, int item, int tid) {
    asm volatile("" : "+v"(tid));
    const int bh = item < 256 ? (item >> 4) : (item - 256), c = item < 256 ? 1 + (item & 15) : 0, b = bh >> 2, h = bh & 3;
    const int C = c == 0 ? 16 : 128, tok0 = c == 0 ? 0 : 16 + 128 * (c - 1);
    const size_t row0 = c == 0 ? (size_t)METAROW + b * 16 : (size_t)b * 2048 + 128 * (c - 1);
    const int wave = __builtin_amdgcn_readfirstlane(tid >> 6), lane = tid & 63, fr = lane & 15, fq = lane >> 4;
    bf16_t* Vt = (bf16_t*)lds; bf16_t* Kt = (bf16_t*)(lds + 69632);
    const float lg = lg2gamma(h);
    const int dim0 = 8 * (4 * wave + fq);
    {
        u32x4 ka[4], kb[4], va[4], vb[4];
#pragma unroll
        for (int i = 0; i < 4; ++i) {
            const int j0 = 2 * (16 * i + fr);
            ka[i] = (u32x4){0u, 0u, 0u, 0u}; kb[i] = ka[i]; va[i] = ka[i]; vb[i] = ka[i];
            if (j0 < C) { const bf16_t* p = Z + (row0 + j0) * PW + h * 256 + dim0; ka[i] = *(const u32x4*)(p + ZK); va[i] = *(const u32x4*)(p + ZV); }
            if (j0 + 1 < C) { const bf16_t* p = Z + (row0 + j0 + 1) * PW + h * 256 + dim0; kb[i] = *(const u32x4*)(p + ZK); vb[i] = *(const u32x4*)(p + ZV); }
        }
#pragma unroll
        for (int i = 0; i < 4; ++i) {
            const int j0 = 2 * (16 * i + fr);
            const float w0 = fexp2((float)(C - 1 - j0) * lg), w1 = fexp2((float)(C - 2 - j0) * lg);
#pragma unroll
            for (int u = 0; u < 8; ++u) {
                const unsigned wa = ka[i][u >> 1], wb = kb[i][u >> 1], xa = va[i][u >> 1], xb = vb[i][u >> 1];
                const unsigned k_a = (u & 1) ? (wa >> 16) : (wa & 0xffffu), k_b = (u & 1) ? (wb >> 16) : (wb & 0xffffu);
                const unsigned v_a = (u & 1) ? (xa >> 16) : (xa & 0xffffu), v_b = (u & 1) ? (xb >> 16) : (xb & 0xffffu);
                *(unsigned*)(Kt + (dim0 + u) * 136 + j0) = cvt_pk_bf16(bf2f(k_a) * w0, bf2f(k_b) * w1);
                *(unsigned*)(Vt + (dim0 + u) * 136 + j0) = v_a | (v_b << 16);
            }
        }
    }
    __syncthreads();
    const int nks = C == 16 ? 1 : 4;
    bf16_t* Uo = U + (size_t)(bh * 17 + c) * 65536;
#pragma unroll 1
    for (int pass = 0; pass < 2; ++pass) {
        f32x4 acc[2][8];
#pragma unroll
        for (int et = 0; et < 2; ++et)
#pragma unroll
            for (int dt = 0; dt < 8; ++dt) acc[et][dt] = (f32x4){0.f, 0.f, 0.f, 0.f};
#pragma unroll
        for (int ks = 0; ks < 4; ++ks) if (ks < nks) {
            const bf16x8 a0 = *(const bf16x8*)(Vt + (32 * wave + fr) * 136 + 32 * ks + 8 * fq);
            const bf16x8 a1 = *(const bf16x8*)(Vt + (32 * wave + 16 + fr) * 136 + 32 * ks + 8 * fq);
#pragma unroll
            for (int dt = 0; dt < 8; ++dt) {
                const bf16x8 bb = *(const bf16x8*)(Kt + (128 * pass + 16 * dt + fr) * 136 + 32 * ks + 8 * fq);
                acc[0][dt] = mfma16(bb, a0, acc[0][dt]); acc[1][dt] = mfma16(bb, a1, acc[1][dt]);
            }
        }
#pragma unroll
        for (int et = 0; et < 2; ++et)
#pragma unroll
            for (int dt = 0; dt < 8; ++dt)
            { u32x2 w; w.x = cvt_pk_bf16(acc[et][dt][0], acc[et][dt][1]); w.y = cvt_pk_bf16(acc[et][dt][2], acc[et][dt][3]);
              *(u32x2*)(Uo + (32 * wave + 16 * et + fr) * 256 + 128 * pass + 16 * dt + 4 * fq) = w; }
    }
    __syncthreads();
}

__device__ __forceinline__ void ret_scan(const bf16_t* U, bf16_t* Sb, float* out, int tid, int G) {
    for (int idx = blockIdx.x * 512 + tid; idx < 16 * 8192; idx += G * 512) {
        const int bh = idx >> 13, rem = idx & 8191, e = rem >> 5, d8 = (rem & 31) * 8, h = bh & 3;
        const float g128 = fexp2(128.f * lg2gamma(h));
        const bf16_t* Up = U + (size_t)bh * 17 * 65536 + e * 256 + d8;
        bf16_t* Sp = Sb + (size_t)bh * 16 * 65536 + e * 256 + d8;
        u32x4 ur[17];
#pragma unroll
        for (int c = 0; c < 17; ++c) ur[c] = *(const u32x4*)(Up + (size_t)c * 65536);
        f32x4 S0, S1; unpack8(ur[0], S0, S1);
#pragma unroll
        for (int c = 0; c < 17; ++c) {
            if (c > 0) { f32x4 u0, u1; unpack8(ur[c], u0, u1); S0 = S0 * g128 + u0; S1 = S1 * g128 + u1; }
            if (c < 16) { u32x4 w; w.x = cvt_pk_bf16(S0[0], S0[1]); w.y = cvt_pk_bf16(S0[2], S0[3]); w.z = cvt_pk_bf16(S1[0], S1[1]); w.w = cvt_pk_bf16(S1[2], S1[3]); *(u32x4*)(Sp + (size_t)c * 65536) = w; }
        }
        float* o = out + OFF_RSP + (size_t)bh * 65536 + (size_t)d8 * 256 + e;
        o[0] = S0[0]; o[256] = S0[1]; o[512] = S0[2]; o[768] = S0[3]; o[1024] = S1[0]; o[1280] = S1[1]; o[1536] = S1[2]; o[1792] = S1[3];
    }
}

__device__ __forceinline__ void retC_item(unsigned char* lds, const bf16_t* Z, const bf16_t* Sb, bf16_t* MIX, int item, int tid) {
    asm volatile("" : "+v"(tid));
    const int bh = item < 256 ? (item >> 4) : (item - 256), c = item < 256 ? 1 + (item & 15) : 0, b = bh >> 2, h = bh & 3;
    const int C = c == 0 ? 16 : 128, tok0 = c == 0 ? 0 : 16 + 128 * (c - 1);
    const size_t row0 = c == 0 ? (size_t)METAROW + b * 16 : (size_t)b * 2048 + 128 * (c - 1);
    const int wave = __builtin_amdgcn_readfirstlane(tid >> 6), lane = tid & 63, fr = lane & 15, fq = lane >> 4;
    bf16_t* Qs = (bf16_t*)lds; bf16_t* Ks = (bf16_t*)(lds + 67584); bf16_t* Vt = Ks;
    const float lg = lg2gamma(h);
    {
        u32x4 vq[8], vk[8];
#pragma unroll
        for (int i = 0; i < 8; ++i) {
            const int q = tid + 512 * i, r = q >> 5, ch = q & 31;
            vq[i] = (u32x4){0u, 0u, 0u, 0u}; vk[i] = vq[i];
            if (r < C) { const bf16_t* p = Z + (row0 + r) * PW + h * 256 + 8 * ch; vq[i] = *(const u32x4*)(p + ZQ); vk[i] = *(const u32x4*)(p + ZK); }
        }
#pragma unroll
        for (int i = 0; i < 8; ++i) { const int q = tid + 512 * i, r = q >> 5, ch = q & 31; *(u32x4*)(Qs + r * 264 + 8 * ch) = vq[i]; *(u32x4*)(Ks + r * 264 + 8 * ch) = vk[i]; }
    }
    const bf16_t* S = Sb + ((size_t)(bh * 16 + (c > 0 ? c - 1 : 0))) * 65536;
    u32x4 vra[4], vrb[4], sr[8];
    {
        const int dim0 = 8 * (4 * wave + fq);
#pragma unroll
        for (int i = 0; i < 4; ++i) {
            const int j0 = 2 * (16 * i + fr);
            vra[i] = (u32x4){0u, 0u, 0u, 0u}; vrb[i] = vra[i];
            if (j0 < C) vra[i] = *(const u32x4*)(Z + (row0 + j0) * PW + ZV + h * 256 + dim0);
            if (j0 + 1 < C) vrb[i] = *(const u32x4*)(Z + (row0 + j0 + 1) * PW + ZV + h * 256 + dim0);
        }
        if (c > 0) {
            int t2 = tid; asm volatile("" : "+v"(t2));
#pragma unroll
            for (int i = 0; i < 8; ++i) { const int q = t2 + 512 * i, r = q >> 5, ch = q & 31; sr[i] = *(const u32x4*)(S + r * 256 + 8 * ch); }
        }
    }
    asm volatile("" ::: "memory");
    __syncthreads();
    const int i0 = 16 * wave; const bool act = i0 < C;
    bf16x8 qf[8];
#pragma unroll
    for (int ks = 0; ks < 8; ++ks) qf[ks] = *(const bf16x8*)(Qs + (i0 + fr) * 264 + 32 * ks + 8 * fq);
    bf16x8 pf[4];
#pragma unroll
    for (int ks2 = 0; ks2 < 4; ++ks2) {
        f32x4 sA = (f32x4){0.f, 0.f, 0.f, 0.f}, sB = sA;
        if (act && 2 * ks2 <= wave) {
#pragma unroll
            for (int ks = 0; ks < 8; ++ks) { const bf16x8 kf = *(const bf16x8*)(Ks + (32 * ks2 + fr) * 264 + 32 * ks + 8 * fq); sA = mfma16(kf, qf[ks], sA); }
        }
        if (act && 2 * ks2 + 1 <= wave) {
#pragma unroll
            for (int ks = 0; ks < 8; ++ks) { const bf16x8 kf = *(const bf16x8*)(Ks + (32 * ks2 + 16 + fr) * 264 + 32 * ks + 8 * fq); sB = mfma16(kf, qf[ks], sB); }
        }
        float pa[4], pb[4];
#pragma unroll
        for (int r = 0; r < 4; ++r) {
            const int dA = (i0 + fr) - (32 * ks2 + 4 * fq + r), dB = dA - 16;
            pa[r] = dA >= 0 ? sA[r] * fexp2((float)dA * lg) : 0.f;
            pb[r] = dB >= 0 ? sB[r] * fexp2((float)dB * lg) : 0.f;
        }
        u32x4 w; w.x = cvt_pk_bf16(pa[0], pa[1]); w.y = cvt_pk_bf16(pa[2], pa[3]); w.z = cvt_pk_bf16(pb[0], pb[1]); w.w = cvt_pk_bf16(pb[2], pb[3]);
        pf[ks2] = as_bf16x8(w);
    }
    __syncthreads();
    {
        const int dim0 = 8 * (4 * wave + fq);
#pragma unroll
        for (int i = 0; i < 4; ++i) {
            const int j0 = 2 * (16 * i + fr);
#pragma unroll
            for (int u = 0; u < 8; ++u) {
                const unsigned xa = vra[i][u >> 1], xb = vrb[i][u >> 1];
                const unsigned v_a = (u & 1) ? (xa >> 16) : (xa & 0xffffu), v_b = (u & 1) ? (xb >> 16) : (xb & 0xffffu);
                *(unsigned*)(Vt + (dim0 + u) * 136 + j0) = v_a | (v_b << 16);
            }
        }
        if (c > 0) {
            int t2 = tid; asm volatile("" : "+v"(t2));
#pragma unroll
            for (int i = 0; i < 8; ++i) { const int q = t2 + 512 * i, r = q >> 5, ch = q & 31; *(u32x4*)(Qs + r * 264 + 8 * ch) = sr[i]; }
#pragma unroll
            for (int i = 0; i < 8; ++i) { const int q = t2 + 512 * i, r = q >> 5, ch = q & 31; sr[i] = *(const u32x4*)(S + (128 + r) * 256 + 8 * ch); }
        }
    }
    asm volatile("" ::: "memory");
    __syncthreads();
    f32x4 acc[16];
#pragma unroll
    for (int et = 0; et < 16; ++et) acc[et] = (f32x4){0.f, 0.f, 0.f, 0.f};
    if (c > 0) {
        if (act) {
#pragma unroll
            for (int et = 0; et < 8; ++et)
            {
#pragma unroll
                for (int ks = 0; ks < 8; ++ks) { const bf16x8 sf = *(const bf16x8*)(Qs + (16 * et + fr) * 264 + 32 * ks + 8 * fq); acc[et] = mfma16(qf[ks], sf, acc[et]); }
                asm volatile("" ::: "memory");
            }
        }
        __syncthreads();
        {
            int t2 = tid; asm volatile("" : "+v"(t2));
#pragma unroll
            for (int i = 0; i < 8; ++i) { const int q = t2 + 512 * i, r = q >> 5, ch = q & 31; *(u32x4*)(Qs + r * 264 + 8 * ch) = sr[i]; }
        }
        __syncthreads();
        if (act) {
#pragma unroll
            for (int et = 8; et < 16; ++et)
            {
#pragma unroll
                for (int ks = 0; ks < 8; ++ks) { const bf16x8 sf = *(const bf16x8*)(Qs + (16 * (et - 8) + fr) * 264 + 32 * ks + 8 * fq); acc[et] = mfma16(qf[ks], sf, acc[et]); }
                asm volatile("" ::: "memory");
            }
#pragma unroll
            for (int r = 0; r < 4; ++r) { const float sc = fexp2((float)(i0 + 4 * fq + r + 1) * lg);
#pragma unroll
                for (int et = 0; et < 16; ++et) acc[et][r] *= sc; }
        }
    }
    if (act) {
#pragma unroll
        for (int et = 0; et < 16; ++et) {
#pragma unroll
            for (int ks2 = 0; ks2 < 4; ++ks2) if (2 * ks2 <= wave) {
                const u32x2 v0 = *(const u32x2*)(Vt + (16 * et + fr) * 136 + 32 * ks2 + 4 * fq), v1 = *(const u32x2*)(Vt + (16 * et + fr) * 136 + 32 * ks2 + 16 + 4 * fq);
                acc[et] = mfma16(pf[ks2], as_bf16x8((u32x4){v0.x, v0.y, v1.x, v1.y}), acc[et]);
            }
            if (et & 1) asm volatile("" ::: "memory");
        }
    }
    __syncthreads();
    if (act) {
        float* T = (float*)lds + wave * (16 * 260);
#pragma unroll
        for (int r = 0; r < 4; ++r) {
            float s = 0.f;
#pragma unroll
            for (int et = 0; et < 16; ++et) s += acc[et][r];
            s += __shfl_xor(s, 1); s += __shfl_xor(s, 2); s += __shfl_xor(s, 4); s += __shfl_xor(s, 8);
            const float mean = s * (1.f / 256.f); float q = 0.f;
#pragma unroll
            for (int et = 0; et < 16; ++et) { const float dl = acc[et][r] - mean; q += dl * dl; }
            q += __shfl_xor(q, 1); q += __shfl_xor(q, 2); q += __shfl_xor(q, 4); q += __shfl_xor(q, 8);
            const float rstd = 1.f / sqrtf(q * (1.f / 256.f) + LN_EPS);
#pragma unroll
            for (int et = 0; et < 16; ++et) T[(4 * fq + r) * 260 + 16 * et + fr] = (acc[et][r] - mean) * rstd;
        }
        asm volatile("s_waitcnt lgkmcnt(0)" ::: "memory");
        int l2 = lane; asm volatile("" : "+v"(l2));
        u32x4 gt8[8];
#pragma unroll
        for (int k = 0; k < 8; ++k) { const int q = l2 + 64 * k, r = q >> 5, ch = q & 31, i = i0 + r; gt8[k] = (u32x4){0u, 0u, 0u, 0u}; if (i < C) gt8[k] = *(const u32x4*)(Z + (row0 + i) * PW + ZG + h * 256 + 8 * ch); }
#pragma unroll
        for (int k = 0; k < 8; ++k) {
            const int q = l2 + 64 * k, r = q >> 5, ch = q & 31, i = i0 + r;
            if (i < C) {
                const f32x4 x0 = *(const f32x4*)(T + r * 260 + 8 * ch), x1 = *(const f32x4*)(T + r * 260 + 8 * ch + 4);
                const u32x4 gg = gt8[k];
                u32x4 w;
                w.x = cvt_pk_bf16(x0[0] * bf2f(gg.x & 0xffffu), x0[1] * bf2f(gg.x >> 16)); w.y = cvt_pk_bf16(x0[2] * bf2f(gg.y & 0xffffu), x0[3] * bf2f(gg.y >> 16));
                w.z = cvt_pk_bf16(x1[0] * bf2f(gg.z & 0xffffu), x1[1] * bf2f(gg.z >> 16)); w.w = cvt_pk_bf16(x1[2] * bf2f(gg.w & 0xffffu), x1[3] * bf2f(gg.w >> 16));
                *(u32x4*)(MIX + (row0 + i) * D + h * 256 + 8 * ch) = w;
            }
        }
    }
    __syncthreads();
}

template <bool SAMPLE>
__device__ __forceinline__ void swa_item(unsigned char* lds, const bf16_t* Z, const float* ck, const float* cv, const float* sinks, bf16_t* MIX, int item, int tid) {
    asm volatile("" : "+v"(tid));
    const int wave = __builtin_amdgcn_readfirstlane(tid >> 6), lane = tid & 63, fr = lane & 15, fq = lane >> 4;
    bf16_t* Kb = (bf16_t*)lds; bf16_t* Vt = (bf16_t*)(lds + 39168);
    int b, blk = 0, g, nkeys, nit, kmin, tbase = 0;
    if (SAMPLE) { b = item >> 1; g = item & 1; nkeys = 136; nit = 1; kmin = 0; }
    else { b = item / 34; const int rem = item - b * 34; blk = rem >> 1; g = rem & 1; nkeys = 256; nit = blk == 16 ? 1 : 8; kmin = blk == 0 ? 128 : 0; tbase = blk * 128 - 128; }
#define SWA_RAW(kk_, ch_, zoff_, cache_, r0_, r1_) do { r0_ = (f32x4){0.f, 0.f, 0.f, 0.f}; r1_ = r0_; \
        if (SAMPLE) { if ((kk_) < 128) { const float* p_ = (cache_) + ((size_t)(b * 128 + (kk_)) * 2 + g) * 64 + 8 * (ch_); r0_ = *(const f32x4*)p_; r1_ = *(const f32x4*)(p_ + 4); } \
                      else if ((kk_) < 136) r0_ = *(const f32x4*)(Z + (size_t)(SROW + b * 8 + (kk_) - 128) * PW + (zoff_) + g * 64 + 8 * (ch_)); } \
        else { const int tp_ = tbase + (kk_); if ((kk_) < 256 && tp_ >= 0 && tp_ < LP) r0_ = *(const f32x4*)(Z + (size_t)prow(b, tp_) * PW + (zoff_) + g * 64 + 8 * (ch_)); } } while (0)
#define SWA_CVT(kk_, r0_, r1_, out_) do { union { f32x4 f; u32x4 u; } x_; x_.f = r0_; out_ = x_.u; \
        if (SAMPLE && (kk_) < 128) { out_.x = cvt_pk_bf16(r0_[0], r0_[1]); out_.y = cvt_pk_bf16(r0_[2], r0_[3]); out_.z = cvt_pk_bf16(r1_[0], r1_[1]); out_.w = cvt_pk_bf16(r1_[2], r1_[3]); } } while (0)
    {
        f32x4 k0[5], k1[5], va0[3], va1[3], vb0[3], vb1[3];
#pragma unroll
        for (int i = 0; i < 5; ++i) { const int q = tid + 512 * i, kk = q >> 3, ch = q & 7; k0[i] = (f32x4){0.f, 0.f, 0.f, 0.f}; k1[i] = k0[i]; if (q < 272 * 8) SWA_RAW(kk, ch, ZSK, ck, k0[i], k1[i]); }
#pragma unroll
        for (int i = 0; i < 3; ++i) { const int q = tid + 512 * i, ch = q / 140, pr = q - ch * 140; va0[i] = (f32x4){0.f, 0.f, 0.f, 0.f}; va1[i] = va0[i]; vb0[i] = va0[i]; vb1[i] = va0[i];
            if (q < 140 * 8) { SWA_RAW(2 * pr, ch, ZSV, cv, va0[i], va1[i]); SWA_RAW(2 * pr + 1, ch, ZSV, cv, vb0[i], vb1[i]); } }
#pragma unroll
        for (int i = 0; i < 5; ++i) { const int q = tid + 512 * i, kk = q >> 3, ch = q & 7; if (q < 272 * 8) { u32x4 v; SWA_CVT(kk, k0[i], k1[i], v); *(u32x4*)(Kb + kk * 72 + 8 * ch) = v; } }
#pragma unroll
        for (int i = 0; i < 3; ++i) {
            const int q = tid + 512 * i, ch = q / 140, pr = q - ch * 140;
            if (q < 140 * 8) {
                u32x4 va, vb; SWA_CVT(2 * pr, va0[i], va1[i], va); SWA_CVT(2 * pr + 1, vb0[i], vb1[i], vb);
#pragma unroll
                for (int u = 0; u < 8; ++u) {
                    const unsigned xa = va[u >> 1], xb = vb[u >> 1];
                    const unsigned v_a = (u & 1) ? (xa >> 16) : (xa & 0xffffu), v_b = (u & 1) ? (xb >> 16) : (xb & 0xffffu);
                    *(unsigned*)(Vt + (8 * ch + u) * 280 + 2 * pr) = v_a | (v_b << 16);
                }
            }
        }
    }
#undef SWA_RAW
#undef SWA_CVT
    __syncthreads();
    const int hq = g * 8 + wave; const float sink = sinks[hq];
#define SWA_LOADQ(it_, d0, d1) do { const int iq_ = 16 * (it_) + fr; bool qv_; size_t rowq_; \
        if (SAMPLE) { qv_ = fr < 8; rowq_ = (size_t)SROW + b * 8 + (fr & 7); } else { const int tq_ = blk * 128 + iq_; qv_ = tq_ < LP; rowq_ = (size_t)prow(b, qv_ ? tq_ : 0); } \
        d0 = (u32x4){0u, 0u, 0u, 0u}; d1 = d0; \
        if (qv_) { const bf16_t* p_ = Z + rowq_ * PW + ZSQ + hq * 64 + 8 * fq; d0 = *(const u32x4*)p_; d1 = *(const u32x4*)(p_ + 32); } } while (0)
    u32x4 q0n, q1n; SWA_LOADQ(0, q0n, q1n);
#pragma unroll 1
    for (int it = 0; it < nit; ++it) {
        const int i0 = 16 * it, iq = i0 + fr;
        const bf16x8 q0 = as_bf16x8(q0n), q1 = as_bf16x8(q1n);
        if (it + 1 < nit) SWA_LOADQ(it + 1, q0n, q1n);
        f32x4 s[10];
#pragma unroll
        for (int jj = 0; jj < 10; ++jj) {
            const bf16_t* kp = Kb + (16 * (it + jj) + fr) * 72 + 8 * fq;
            s[jj] = mfma16(*(const bf16x8*)kp, q0, (f32x4){0.f, 0.f, 0.f, 0.f});
            s[jj] = mfma16(*(const bf16x8*)(kp + 32), q1, s[jj]);
        }
        float mx = sink;
#pragma unroll
        for (int jj = 0; jj < 10; ++jj)
#pragma unroll
            for (int r = 0; r < 4; ++r) {
                const int kk = 16 * (it + jj) + 4 * fq + r;
                const bool ok = (kk > iq) && (kk <= iq + 128) && (kk >= kmin) && (kk < nkeys);
                s[jj][r] = ok ? s[jj][r] : -1e30f; mx = fmaxf(mx, s[jj][r]);
            }
        mx = fmaxf(mx, __shfl_xor(mx, 16)); mx = fmaxf(mx, __shfl_xor(mx, 32));
        float sum = 0.f;
#pragma unroll
        for (int jj = 0; jj < 10; ++jj)
#pragma unroll
            for (int r = 0; r < 4; ++r) { s[jj][r] = fexp(s[jj][r] - mx); sum += s[jj][r]; }
        sum += __shfl_xor(sum, 16); sum += __shfl_xor(sum, 32);
        const float inv = 1.f / (sum + fexp(sink - mx));
        bf16x8 pf[5];
#pragma unroll
        for (int k2 = 0; k2 < 5; ++k2) {
            u32x4 w; w.x = cvt_pk_bf16(s[2 * k2][0] * inv, s[2 * k2][1] * inv); w.y = cvt_pk_bf16(s[2 * k2][2] * inv, s[2 * k2][3] * inv);
            w.z = cvt_pk_bf16(s[2 * k2 + 1][0] * inv, s[2 * k2 + 1][1] * inv); w.w = cvt_pk_bf16(s[2 * k2 + 1][2] * inv, s[2 * k2 + 1][3] * inv);
            pf[k2] = as_bf16x8(w);
        }
        f32x4 o[4];
#pragma unroll
        for (int dt = 0; dt < 4; ++dt) {
            o[dt] = (f32x4){0.f, 0.f, 0.f, 0.f};
#pragma unroll
            for (int k2 = 0; k2 < 5; ++k2) {
                const bf16_t* vp = Vt + (16 * dt + fr) * 280 + 16 * (it + 2 * k2) + 4 * fq;
                const u32x2 v0 = *(const u32x2*)vp, v1 = *(const u32x2*)(vp + 16);
                o[dt] = mfma16(pf[k2], as_bf16x8((u32x4){v0.x, v0.y, v1.x, v1.y}), o[dt]);
            }
        }
#pragma unroll
        for (int r = 0; r < 4; ++r) {
            const int i = i0 + 4 * fq + r; bool ok; size_t row;
            if (SAMPLE) { ok = i < 8; row = (size_t)SROW + b * 8 + i; } else { const int tq = blk * 128 + i; ok = tq < LP; row = (size_t)prow(b, ok ? tq : 0); }
            if (ok) { bf16_t* mp = MIX + row * D + 1024 + hq * 64 + fr;
#pragma unroll
                for (int dt = 0; dt < 4; ++dt) mp[16 * dt] = f2bf(o[dt][r]); }
        }
    }
    __syncthreads();
}

#undef SWA_LOADQ
template <int MODE>
__device__ __forceinline__ void retS_item(unsigned char* lds, const bf16_t* Z, const float* state, float* out, bf16_t* MIX, bf16_t* SKV, int item, int tid) {
    asm volatile("" : "+v"(tid));
    const int b = item >> 2, h = item & 3; const size_t row0 = (size_t)SROW + b * 8;
    const int wave = __builtin_amdgcn_readfirstlane(tid >> 6), lane = tid & 63;
    float* qT = (float*)lds; float* kT = qT + 2048; float* vS = kT + 2048; float* sc = vS + 2048; float* cp = sc + 64;
    const float lg = lg2gamma(h);
    {
        const int t = tid >> 6, d4 = (tid & 63) * 4;
        bf16_t* skv = SKV + (size_t)item * 4096 + t * 256 + d4;
        u32x2 rk, rv;
        if (MODE == 0) {
            const bf16_t* p = Z + (row0 + t) * PW + h * 256 + d4;
            const u32x2 rq = *(const u32x2*)(p + ZQ); rk = *(const u32x2*)(p + ZK); rv = *(const u32x2*)(p + ZV);
            *(u32x2*)skv = rk; *(u32x2*)(skv + 2048) = rv;
            qT[(d4 + 0) * 8 + t] = bf2f(rq.x & 0xffffu); qT[(d4 + 1) * 8 + t] = bf2f(rq.x >> 16); qT[(d4 + 2) * 8 + t] = bf2f(rq.y & 0xffffu); qT[(d4 + 3) * 8 + t] = bf2f(rq.y >> 16);
        } else { rk = *(const u32x2*)skv; rv = *(const u32x2*)(skv + 2048); }
        kT[(d4 + 0) * 8 + t] = bf2f(rk.x & 0xffffu); kT[(d4 + 1) * 8 + t] = bf2f(rk.x >> 16); kT[(d4 + 2) * 8 + t] = bf2f(rk.y & 0xffffu); kT[(d4 + 3) * 8 + t] = bf2f(rk.y >> 16);
        *(f32x4*)(vS + t * 256 + d4) = (f32x4){bf2f(rv.x & 0xffffu), bf2f(rv.x >> 16), bf2f(rv.y & 0xffffu), bf2f(rv.y >> 16)};
    }
    __syncthreads();
    if (MODE == 0) {
        const int i = tid >> 6, j = (tid >> 3) & 7, part = tid & 7; float s = 0.f;
#pragma unroll 8
        for (int dd = 0; dd < 32; ++dd) { const int d = part * 32 + dd; s += qT[d * 8 + i] * kT[d * 8 + j]; }
        s += __shfl_xor(s, 1); s += __shfl_xor(s, 2); s += __shfl_xor(s, 4);
        if (part == 0) sc[i * 8 + j] = j <= i ? s * fexp2((float)(i - j) * lg) : 0.f;
    }
    const float* S = state + (size_t)(b * 4 + h) * 65536; float* SO = out + OFF_RSS + (size_t)(b * 4 + h) * 65536;
    const int e4 = lane * 4;
    u32x2 gg = (u32x2){0u, 0u};
    if (MODE == 0) gg = *(const u32x2*)(Z + (row0 + wave) * PW + ZG + h * 256 + e4);
    f32x4 vv[8], cr[8];
#pragma unroll
    for (int j = 0; j < 8; ++j) { vv[j] = *(const f32x4*)(vS + j * 256 + e4) * fexp2((float)(7 - j) * lg); cr[j] = (f32x4){0.f, 0.f, 0.f, 0.f}; }
    const float g8 = fexp2(8.f * lg);
#define RETS_LOAD(buf, db) _Pragma("unroll") for (int u = 0; u < 8; ++u) buf[u] = __builtin_nontemporal_load((const f32x4*)(S + (size_t)(32 * wave + (db) + u) * 256 + e4))
#define RETS_COMP(buf, db) _Pragma("unroll") for (int u = 0; u < 8; ++u) { \
        const int d = 32 * wave + (db) + u; \
        if (MODE == 0) { \
            const f32x4 qa = *(const f32x4*)(qT + d * 8), qb = *(const f32x4*)(qT + d * 8 + 4); \
            cr[0] += buf[u] * qa[0]; cr[1] += buf[u] * qa[1]; cr[2] += buf[u] * qa[2]; cr[3] += buf[u] * qa[3]; \
            cr[4] += buf[u] * qb[0]; cr[5] += buf[u] * qb[1]; cr[6] += buf[u] * qb[2]; cr[7] += buf[u] * qb[3]; \
        } else { \
            const f32x4 ka = *(const f32x4*)(kT + d * 8), kb = *(const f32x4*)(kT + d * 8 + 4); \
            f32x4 sn = buf[u] * g8; \
            sn += vv[0] * ka[0]; sn += vv[1] * ka[1]; sn += vv[2] * ka[2]; sn += vv[3] * ka[3]; \
            sn += vv[4] * kb[0]; sn += vv[5] * kb[1]; sn += vv[6] * kb[2]; sn += vv[7] * kb[3]; \
            __builtin_nontemporal_store(sn, (f32x4*)(SO + (size_t)d * 256 + e4)); } }
    {
        f32x4 sa[8], sb[8];
        RETS_LOAD(sa, 0); RETS_LOAD(sb, 8);
        RETS_COMP(sa, 0); RETS_LOAD(sa, 16);
        RETS_COMP(sb, 8); RETS_LOAD(sb, 24);
        RETS_COMP(sa, 16); RETS_COMP(sb, 24);
    }
#undef RETS_LOAD
#undef RETS_COMP
    if (MODE == 0) {
#pragma unroll
        for (int i = 0; i < 8; ++i) *(f32x4*)(cp + (wave * 8 + i) * 256 + e4) = cr[i];
        __syncthreads();
        const int i = wave; f32x4 o = (f32x4){0.f, 0.f, 0.f, 0.f};
#pragma unroll
        for (int w8 = 0; w8 < 8; ++w8) o += *(const f32x4*)(cp + (w8 * 8 + i) * 256 + e4);
        o *= fexp2((float)(i + 1) * lg);
#pragma unroll
        for (int j = 0; j < 8; ++j) o += *(const f32x4*)(vS + j * 256 + e4) * sc[i * 8 + j];
        const float mean = wave_sum((o[0] + o[1]) + (o[2] + o[3])) * (1.f / 256.f);
        const f32x4 dl = o - mean;
        const float var = wave_sum((dl[0] * dl[0] + dl[1] * dl[1]) + (dl[2] * dl[2] + dl[3] * dl[3])) * (1.f / 256.f);
        const float rstd = 1.f / sqrtf(var + LN_EPS);
        u32x2 w; w.x = cvt_pk_bf16(dl[0] * rstd * bf2f(gg.x & 0xffffu), dl[1] * rstd * bf2f(gg.x >> 16)); w.y = cvt_pk_bf16(dl[2] * rstd * bf2f(gg.y & 0xffffu), dl[3] * rstd * bf2f(gg.y >> 16));
        *(u32x2*)(MIX + (row0 + i) * D + h * 256 + e4) = w;
    }
    __syncthreads();
}

constexpr int NPHASE = 10;
__global__ void __launch_bounds__(512) fwd(Args a_unused) {
    extern __shared__ __attribute__((aligned(16))) unsigned char lds[];
    int lo, hi; { KArgs a = kargs(); lo = a->ph_lo; hi = a->ph_hi; }
    if (hi - lo > 1) {
        if (threadIdx.x == 0) { ((volatile LAS unsigned*)(lds + LDS_CTL))[0] = 0u; ((volatile LAS unsigned*)(lds + LDS_CTL))[1] = 0u; }
        __syncthreads();
        if (threadIdx.x == 0) { KArgs a = kargs(); (void)xb_add((unsigned*)(a->ws + WS_BAR) + XB_XCNT(xb_xcc_id()), 1u); }
    }
#define IN(k) (lo <= (k) && (k) < hi)
#define SEAM(k) do { if (IN(k) && IN((k) + 1)) { for (int _r = 0; _r < REPSYNC; ++_r) { KArgs _a = kargs(); xcd_barrier((unsigned*)(_a->ws + WS_BAR), (volatile LAS unsigned*)(lds + LDS_CTL)); } } } while (0)
#define WSP(T, off) ((T)(a->ws + (off)))
    if (IN(0)) { for (int _r = 0; _r < REP0; ++_r) { KArgs a = kargs(); phase0(a, lds, ltid(), gridDim.x); __syncthreads(); } }
    SEAM(0);
    if (IN(1)) {
        KArgs a = kargs(); const int G = gridDim.x;
        pg8::Gemm g{WSP(const bf16_t*, WS_H), WSP(const bf16_t*, WS_WIN), D, D, PW / 256, 0}; pg8::StaticOrder S; S.init(MR, PW, G, (int)blockIdx.x, 9);
        const float* cosR = WSP(const float*, WS_TAB);
        EpiIn E{WSP(bf16_t*, WS_Z), cosR, cosR + NPOS * 128, cosR + 2 * NPOS * 128, cosR + 2 * NPOS * 128 + NPOS * 8, a->out};
        for (int _r = 0; _r < 1 + ((REPG >> 0) & 1); ++_r) pg8::gemm_phase<EpiIn>((LAS unsigned char*)lds, g, S, E);
    }
    SEAM(1);
    for (int _rm = 0; _rm < REPMIX; ++_rm) {
    if (_rm > 0) { KArgs _a = kargs(); xcd_barrier((unsigned*)(_a->ws + WS_BAR), (volatile LAS unsigned*)(lds + LDS_CTL)); }
    if (IN(2)) {
        KArgs a = kargs(); const int G = gridDim.x, tid = ltid();
        bf16_t* Z = WSP(bf16_t*, WS_Z); bf16_t* MIX = WSP(bf16_t*, WS_MIX);
        unsigned* head = (unsigned*)(a->ws + WS_BAR) + 16;
        volatile LAS unsigned* qw = (volatile LAS unsigned*)(lds + LDS_CTL) + 2;
        for (;;) {
            if (tid == 0) *qw = __hip_atomic_fetch_add(head, 1u, __ATOMIC_RELAXED, __HIP_MEMORY_SCOPE_AGENT);
            __syncthreads();
            const int q = (int)*qw;
            if (q >= 136 + 512 + 272 + 256 + 128) break;
            if (q < 136) swa_item<false>(lds, Z, nullptr, nullptr, a->in[10], MIX, q, tid);
            else if (q < 648) retS_item<0>(lds, Z, a->in[2], a->out, MIX, WSP(bf16_t*, WS_SKV), q - 136, tid);
            else if (q < 920) retA_item(lds, Z, WSP(bf16_t*, WS_U), q - 648, tid);
            else if (q < 1176) swa_item<true>(lds, Z, a->in[3], a->in[4], a->in[10], MIX, q - 920, tid);
            else { shift_item(a->in[3], a->in[4], a->out, q - 1176, tid); __syncthreads(); }
        }
    }
    SEAM(2);
    if (IN(3)) { KArgs a = kargs(); ret_scan(WSP(const bf16_t*, WS_U), WSP(bf16_t*, WS_SB), a->out, ltid(), gridDim.x); }
    SEAM(3);
    if (IN(4)) { KArgs a = kargs(); const int G = gridDim.x, tid = ltid(); for (int it = blockIdx.x; it < 256; it += G) retC_item(lds, WSP(const bf16_t*, WS_Z), WSP(const bf16_t*, WS_SB), WSP(bf16_t*, WS_MIX), it, tid); }
    }
    SEAM(4);
    if (IN(5)) {
        KArgs a = kargs(); const int G = gridDim.x;
        pg8::Gemm g{WSP(const bf16_t*, WS_MIX), WSP(const bf16_t*, WS_WO), D, D / 2, D / 256, (size_t)(D / 2) * 2}; pg8::StaticOrder S; S.init(MR, 2 * D, G, (int)blockIdx.x);
        EpiRes E{WSP(bf16_t*, WS_PRE), WSP(const bf16_t*, WS_H), WSP(bf16_t*, WS_Z)};
        for (int _r = 0; _r < 1 + ((REPG >> 1) & 1); ++_r) pg8::gemm_phase<EpiRes>((LAS unsigned char*)lds, g, S, E);
        const int nun = (MR / 256) * (2 * D / 256), rounds = (nun + G - 1) / G, first_idle = nun - (rounds - 1) * G;
        if (first_idle < G) { if ((int)blockIdx.x >= first_idle) { const int tid = ltid(); late_transposes(a, lds, tid, ((int)blockIdx.x - first_idle) * 8 + (tid >> 6), (G - first_idle) * 8); } }
        else { const int tid = ltid(); late_transposes(a, lds, tid, (int)blockIdx.x * 8 + (tid >> 6), G * 8); }
    }
    SEAM(5);
    if (IN(6)) {
        KArgs a = kargs(); const int G = gridDim.x, tid = ltid(), lane = tid & 63, wave = tid >> 6;
        for (int _r = 0; _r < REPLN; ++_r) for (int row = blockIdx.x * 8 + wave; row < MR; row += 2 * G * 8) {
            const int rowb = row + G * 8; const bool hasB = rowb < MR; const int rb = hasB ? rowb : row;
            ln2_bf16<false>(WSP(const bf16_t*, WS_PRE) + (size_t)row * D, WSP(const bf16_t*, WS_Z) + (size_t)row * D, WSP(const bf16_t*, WS_PRE) + (size_t)rb * D, WSP(const bf16_t*, WS_Z) + (size_t)rb * D, hasB,
                            a->in[11], a->in[12], WSP(bf16_t*, WS_H) + (size_t)row * D, WSP(bf16_t*, WS_H) + (size_t)rb * D, lane);
        }
    }
    SEAM(6);
    if (IN(7)) {
        KArgs a = kargs(); const int G = gridDim.x, c = (int)blockIdx.x;
        const pg8::Gemm gu{WSP(const bf16_t*, WS_H), WSP(const bf16_t*, WS_WGU), D, D, 2 * FF / 256, 0};
        const pg8::Gemm gd{WSP(const bf16_t*, WS_A2), WSP(const bf16_t*, WS_WD), FF, FF / 2, D / 256, (size_t)(FF / 2) * 2};
        const EpiGlu Eu{WSP(bf16_t*, WS_A2)};
        const EpiRes Ed{WSP(bf16_t*, WS_PRE), WSP(const bf16_t*, WS_H), WSP(bf16_t*, WS_PRE2)};
        constexpr int NP = MR / 256;
        pg8::StaticOrder S; S.init(MR - 512, 2 * FF, G, c); S.tailM = 2;
        const int nup = S.total(), nfull = nup / G, ntail = nup - nfull * G;
        int np1 = (G - ntail) / 16; if (np1 > NP - 2) np1 = NP - 2;
        const bool cut = ntail > 0 && ntail % 8 == 0 && (G - ntail) == np1 * 16 && G % 8 == 0 && (nfull * G - S.nwg) >= 0 && (hi - lo > 1);
        S.ilim = cut ? nfull : (1 << 20);
        pg8::gemm_phase<EpiGlu>((LAS unsigned char*)lds, gu, S, Eu);
        if (hi - lo > 1) { KArgs _a = kargs(); xcd_barrier((unsigned*)(_a->ws + WS_BAR), (volatile LAS unsigned*)(lds + LDS_CTL)); }
        if (cut) {
            if (c < ntail) {
                S.i0 = nfull; S.ilim = 1 << 20; pg8::gemm_phase<EpiGlu>((LAS unsigned char*)lds, gu, S, Eu);
                const int tid = ltid();
                unsigned* head = (unsigned*)(a->ws + WS_BAR) + 32;
                volatile LAS unsigned* qw = (volatile LAS unsigned*)(lds + LDS_CTL) + 2;
                if (tid == 0) *qw = __hip_atomic_fetch_add(head, 1u, __ATOMIC_RELAXED, __HIP_MEMORY_SCOPE_AGENT);
                __syncthreads();
                const int q = (int)*qw;
                if (q < 512) retS_item<1>(lds, nullptr, a->in[2], a->out, nullptr, WSP(bf16_t*, WS_SKV), q, tid);
            }
            else { pg8::StaticOrder T; T.init(np1 * 256, 2 * D, G - ntail, c - ntail); pg8::gemm_phase<EpiRes>((LAS unsigned char*)lds, gd, T, Ed); }
            { KArgs _a = kargs(); xcd_barrier((unsigned*)(_a->ws + WS_BAR), (volatile LAS unsigned*)(lds + LDS_CTL)); }
        }
        {
            const int p0 = cut ? np1 : 0;
            pg8::StaticOrder T; T.init((NP - p0) * 256, 2 * D, G, c); T.pm0 = p0;
            pg8::gemm_phase<EpiRes>((LAS unsigned char*)lds, gd, T, Ed);
        }
        {
            const int tid = ltid();
            unsigned* head = (unsigned*)(a->ws + WS_BAR) + 32;
            volatile LAS unsigned* qw = (volatile LAS unsigned*)(lds + LDS_CTL) + 2;
            for (;;) {
                if (tid == 0) *qw = __hip_atomic_fetch_add(head, 1u, __ATOMIC_RELAXED, __HIP_MEMORY_SCOPE_AGENT);
                __syncthreads();
                const int q = (int)*qw;
                if (q >= 512) break;
                retS_item<1>(lds, nullptr, a->in[2], a->out, nullptr, WSP(bf16_t*, WS_SKV), q, tid);
            }
        }
    }
    SEAM(8);
    if (IN(9)) {
        KArgs a = kargs(); const int G = gridDim.x, tid = ltid(), lane = tid & 63, wave = tid >> 6;
        for (int _r = 0; _r < REPLN; ++_r) for (int row = blockIdx.x * 8 + wave; row < MR; row += 2 * G * 8) {
            const int rowb = row + G * 8; const bool hasB = rowb < MR; const int rb = hasB ? rowb : row;
            float* da = row < SROW ? a->out + OFF_YP + (size_t)row * D : a->out + OFF_YS + (size_t)(row - SROW) * D;
            float* db = rb < SROW ? a->out + OFF_YP + (size_t)rb * D : a->out + OFF_YS + (size_t)(rb - SROW) * D;
            ln2_bf16<true>(WSP(const bf16_t*, WS_PRE) + (size_t)row * D, WSP(const bf16_t*, WS_PRE2) + (size_t)row * D, WSP(const bf16_t*, WS_PRE) + (size_t)rb * D, WSP(const bf16_t*, WS_PRE2) + (size_t)rb * D, hasB,
                           a->in[16], a->in[17], da, db, lane);
        }
    }
#undef IN
#undef SEAM
#undef WSP
}

extern "C" void kernel_launch(void* const* d_in, const int* in_sizes, int n_in, void* d_out, int out_size, void* d_ws, size_t ws_size, hipStream_t stream) {
    static int grid = 0;
    if (grid == 0) {
        if (n_in != 18 || ws_size < WS_END) { fprintf(stderr, "kernel_launch: unexpected n_in %d / ws_size %zu (need %zu)\n", n_in, ws_size, (size_t)WS_END); grid = -1; return; }
        int dev = 0, cus = 0, per_cu = 0;
        (void)hipGetDevice(&dev);
        (void)hipDeviceGetAttribute(&cus, hipDeviceAttributeMultiprocessorCount, dev);
        (void)hipFuncSetAttribute((const void*)fwd, hipFuncAttributeMaxDynamicSharedMemorySize, LDS_BYTES);
        (void)hipOccupancyMaxActiveBlocksPerMultiprocessor(&per_cu, (const void*)fwd, 512, LDS_BYTES);
        if (per_cu < 1) { fprintf(stderr, "kernel_launch: occupancy query reports %d blocks per CU\n", per_cu); per_cu = 1; }
        grid = cus * 1;
        (void)hipGetLastError();
    }
    if (grid < 0) return;
    Args a{};
    for (int i = 0; i < 18; ++i) a.in[i] = (const float*)d_in[i];
    a.out = (float*)d_out; a.ws = (unsigned char*)d_ws;
#if N_LAUNCH_MODE == 0
    (void)hipMemsetAsync((char*)d_ws + WS_BAR, 0, 3456 * 4, stream);
    a.ph_lo = 0; a.ph_hi = NPHASE;
    void* args[] = {&a};
    hipError_t e = hipLaunchCooperativeKernel((const void*)fwd, dim3(grid), dim3(512), args, LDS_BYTES, stream);
    if (e != hipSuccess) fprintf(stderr, "cooperative launch failed: %s (grid %d)\n", hipGetErrorString(e), grid);
#else
    for (int p = 0; p < NPHASE; ++p) {
        a.ph_lo = p; a.ph_hi = p + 1;
        void* args[] = {&a};
        hipError_t e = hipLaunchCooperativeKernel((const void*)fwd, dim3(grid), dim3(512), args, LDS_BYTES, stream);
        if (e != hipSuccess) fprintf(stderr, "launch %d failed: %s (grid %d)\n", p, hipGetErrorString(e), grid);
    }
#endif
}
```
